# Optimizing an MI355X kernel written in HIP

```python
import jax, jax.numpy as jnp
from jax import lax
import numpy as np

D_MODEL = 2048
BATCH = 2
SEQ = 16384
DEPTH = 2

RET_WIDTH = D_MODEL // 2
RET_HEADS = 4
RET_HEAD_DIM = RET_WIDTH // RET_HEADS
RET_CHUNK = 128
ROPE_BASE = 10000.0
SG_WIDTH = D_MODEL - RET_WIDTH
SG_GROUPS = 8
SG_GROUP_DIM = SG_WIDTH // SG_GROUPS
SG_CHUNK = 128
MIX_WIDTH = RET_WIDTH + SG_WIDTH
IN_COLS = 4 * RET_WIDTH + 2 * SG_WIDTH
N_EXPERTS = 32
N_EXPERT_GROUPS = 8
EXPERTS_PER_GROUP = N_EXPERTS // N_EXPERT_GROUPS
TOP_K = 2
D_FF_EXPERT = 512
DISPATCH_BLOCK = 256
N_ADA = 6
EPS = 1e-6

kernel_name = "hybrid_retention_spatialgate_grouped_moe_adaln"


def _rms(x):
    xf = x.astype(jnp.float32)
    return xf * lax.rsqrt(jnp.mean(xf * xf, axis=-1, keepdims=True) + EPS)


def rms_norm(x, w):
    return (_rms(x) * w.astype(jnp.float32)).astype(x.dtype)


def rotary(x, positions):
    half = x.shape[-1] // 2
    inv_freq = ROPE_BASE ** (-jnp.arange(half, dtype=jnp.float32) / half)
    ang = positions.astype(jnp.float32)[..., None] * inv_freq
    cos = jnp.cos(ang)[:, :, None, :].astype(x.dtype)
    sin = jnp.sin(ang)[:, :, None, :].astype(x.dtype)
    x1, x2 = x[..., :half], x[..., half:]
    return jnp.concatenate([x1 * cos - x2 * sin, x2 * cos + x1 * sin], axis=-1)


def retention_chunkwise(q, k, v):
    bsz, seq, heads, dk = q.shape
    dv = v.shape[-1]
    n_chunks = seq // RET_CHUNK
    log_gamma = jnp.log1p(-jnp.exp2(-5.0 - jnp.arange(heads, dtype=jnp.float32)))
    pos = jnp.arange(RET_CHUNK, dtype=jnp.float32)
    diff = pos[:, None] - pos[None, :]
    decay_mask = jnp.where(diff >= 0, jnp.exp(log_gamma[:, None, None] * jnp.maximum(diff, 0.0)), 0.0).astype(q.dtype)
    q_decay = jnp.exp(log_gamma[:, None] * (pos + 1.0)).astype(q.dtype)[None, :, :, None]
    k_decay = jnp.exp(log_gamma[:, None] * (RET_CHUNK - 1.0 - pos)).astype(q.dtype)[None, :, :, None]
    chunk_decay = jnp.exp(log_gamma * RET_CHUNK).astype(q.dtype)[None, :, None, None]

    def to_chunks(t):
        return t.reshape(bsz, n_chunks, RET_CHUNK, heads, t.shape[-1]).transpose(1, 0, 3, 2, 4)

    def step(state, qkv):
        qc, kc, vc = qkv
        scores = jnp.einsum('bhnd,bhmd->bhnm', qc, kc) * decay_mask
        intra = jnp.einsum('bhnm,bhme->bhne', scores, vc)
        cross = jnp.einsum('bhnd,bhde->bhne', qc, state) * q_decay
        new_state = state * chunk_decay + jnp.einsum('bhmd,bhme->bhde', kc * k_decay, vc)
        return new_state, intra + cross

    state0 = jnp.zeros((bsz, heads, dk, dv), q.dtype)
    _, out = lax.scan(step, state0, (to_chunks(q), to_chunks(k), to_chunks(v)))
    return out.transpose(1, 0, 3, 2, 4).reshape(bsz, seq, heads, dv)


def spatial_gating(u, v, w_s, b_s):
    bsz, seq, groups, dg = v.shape
    n_chunks = seq // SG_CHUNK
    v = _rms(v).astype(u.dtype)
    causal = jnp.tril(jnp.ones((SG_CHUNK, SG_CHUNK), dtype=w_s.dtype))
    vc = v.reshape(bsz, n_chunks, SG_CHUNK, groups, dg)
    z = jnp.einsum('gnm,bkmgd->bkngd', w_s * causal, vc) + b_s.T[None, None, :, :, None]
    return u * z.reshape(bsz, seq, groups, dg)


def shared_router_moe(h, w_router, router_bias, w1, w3, w2):
    bsz, seq, d = h.shape
    xt = h.reshape(-1, d)
    n_tok = xt.shape[0]
    scores = jax.nn.sigmoid(xt.astype(jnp.float32) @ w_router.astype(jnp.float32))
    biased = (scores + router_bias.astype(jnp.float32)).reshape(n_tok, N_EXPERT_GROUPS, EXPERTS_PER_GROUP)
    group_score = lax.top_k(biased, 2)[0].sum(-1)
    g_sel = jnp.argmax(group_score, axis=-1).astype(jnp.int32)
    in_group = jnp.take_along_axis(biased, g_sel[:, None, None], axis=1)[:, 0]
    _, local = lax.top_k(in_group, TOP_K)
    expert_id = g_sel[:, None] * EXPERTS_PER_GROUP + local.astype(jnp.int32)
    gate = jnp.take_along_axis(scores, expert_id, axis=1)
    gate = gate / jnp.sum(gate, axis=-1, keepdims=True)

    n_assign = n_tok * TOP_K
    flat_e = expert_id.reshape(-1)
    flat_tok = jnp.repeat(jnp.arange(n_tok, dtype=jnp.int32), TOP_K)
    flat_gate = gate.reshape(-1)
    order = jnp.argsort(flat_e)
    sorted_e = flat_e[order]
    counts = jnp.bincount(flat_e, length=N_EXPERTS)
    starts = jnp.cumsum(counts) - counts
    padded = (counts + DISPATCH_BLOCK - 1) // DISPATCH_BLOCK * DISPATCH_BLOCK
    pad_ends = jnp.cumsum(padded)
    pad_starts = pad_ends - padded
    dest = pad_starts[sorted_e] + (jnp.arange(n_assign, dtype=jnp.int32) - starts[sorted_e])
    n_blocks = -(-n_assign // DISPATCH_BLOCK) + N_EXPERTS
    n_slots = n_blocks * DISPATCH_BLOCK
    slot_tok = jnp.zeros((n_slots,), jnp.int32).at[dest].set(flat_tok[order])
    slot_gate = jnp.zeros((n_slots,), jnp.float32).at[dest].set(flat_gate[order])
    block_start = jnp.arange(n_blocks, dtype=pad_ends.dtype) * DISPATCH_BLOCK
    block_expert = jnp.minimum(jnp.searchsorted(pad_ends, block_start, side='right'), N_EXPERTS - 1)
    xg = xt[slot_tok].reshape(n_blocks, DISPATCH_BLOCK, d)

    def expert_block(args):
        xb, e = args
        return (jax.nn.silu(xb @ w1[e]) * (xb @ w3[e])) @ w2[e]

    yg = lax.map(expert_block, (xg, block_expert)).reshape(n_slots, d)
    out = jnp.zeros_like(xt).at[slot_tok].add(yg * slot_gate[:, None].astype(yg.dtype))
    return out.reshape(bsz, seq, d)


def setup_inputs(seed: int = 0) -> dict:
    key = jax.random.key(seed)
    ks = jax.random.split(key, 18)
    nrm = jax.random.normal
    f32 = jnp.float32
    x = nrm(ks[0], (BATCH, SEQ, D_MODEL), f32)
    c = nrm(ks[1], (BATCH, D_MODEL), f32)
    positions = jnp.broadcast_to(jnp.arange(SEQ, dtype=jnp.int32)[None, :], (BATCH, SEQ))
    w_ada = nrm(ks[2], (DEPTH, D_MODEL, N_ADA * D_MODEL), f32) * (0.5 * D_MODEL ** -0.5)
    b_ada = 0.02 * nrm(ks[3], (DEPTH, N_ADA * D_MODEL), f32)
    norm1_w = 1.0 + 0.05 * nrm(ks[4], (DEPTH, D_MODEL), f32)
    norm2_w = 1.0 + 0.05 * nrm(ks[5], (DEPTH, D_MODEL), f32)
    w_in = nrm(ks[6], (DEPTH, D_MODEL, IN_COLS), f32) * D_MODEL ** -0.5
    w_out = nrm(ks[7], (DEPTH, MIX_WIDTH, D_MODEL), f32) * MIX_WIDTH ** -0.5
    ret_norm_w = 1.0 + 0.05 * nrm(ks[8], (DEPTH, RET_WIDTH), f32)
    sg_w_s = nrm(ks[9], (DEPTH, SG_GROUPS, SG_CHUNK, SG_CHUNK), f32) * SG_CHUNK ** -0.5
    sg_b_s = 1.0 + 0.1 * nrm(ks[10], (DEPTH, SG_GROUPS, SG_CHUNK), f32)
    w_router = nrm(ks[11], (D_MODEL, N_EXPERTS), f32) * D_MODEL ** -0.5
    router_bias = 0.01 * nrm(ks[12], (N_EXPERTS,), f32)
    w1 = nrm(ks[13], (DEPTH, N_EXPERTS, D_MODEL, D_FF_EXPERT), f32) * D_MODEL ** -0.5
    w3 = nrm(ks[14], (DEPTH, N_EXPERTS, D_MODEL, D_FF_EXPERT), f32) * D_MODEL ** -0.5
    w2 = nrm(ks[15], (DEPTH, N_EXPERTS, D_FF_EXPERT, D_MODEL), f32) * D_FF_EXPERT ** -0.5
    final_norm_w = 1.0 + 0.05 * nrm(ks[16], (D_MODEL,), f32)
    return {"x": x, "c": c, "positions": positions, "w_ada": w_ada, "b_ada": b_ada,
            "norm1_w": norm1_w, "norm2_w": norm2_w, "w_in": w_in, "w_out": w_out,
            "ret_norm_w": ret_norm_w, "sg_w_s": sg_w_s, "sg_b_s": sg_b_s,
            "w_router": w_router, "router_bias": router_bias, "w1": w1, "w3": w3, "w2": w2,
            "final_norm_w": final_norm_w}


def reference(x, c, positions, w_ada, b_ada, norm1_w, norm2_w, w_in, w_out, ret_norm_w,
              sg_w_s, sg_b_s, w_router, router_bias, w1, w3, w2, final_norm_w):
    bsz, seq, _ = x.shape
    c_act = jax.nn.silu(c)
    split_cols = [RET_WIDTH, 2 * RET_WIDTH, 3 * RET_WIDTH, 4 * RET_WIDTH, 4 * RET_WIDTH + SG_WIDTH]
    for layer in range(DEPTH):
        mod = c_act @ w_ada[layer] + b_ada[layer]
        shift1, scale1, gate1, shift2, scale2, gate2 = jnp.split(mod, N_ADA, axis=-1)

        h = rms_norm(x, norm1_w[layer]) * (1 + scale1[:, None]) + shift1[:, None]
        proj = h @ w_in[layer]
        q, k, v, g, u, vs = jnp.split(proj, split_cols, axis=-1)
        q = rotary(q.reshape(bsz, seq, RET_HEADS, RET_HEAD_DIM), positions)
        k = rotary(k.reshape(bsz, seq, RET_HEADS, RET_HEAD_DIM), positions) * RET_HEAD_DIM ** -0.5
        v = v.reshape(bsz, seq, RET_HEADS, RET_HEAD_DIM)
        ret = retention_chunkwise(q, k, v)
        ret = rms_norm(ret, ret_norm_w[layer].reshape(RET_HEADS, RET_HEAD_DIM)).reshape(bsz, seq, RET_WIDTH) * jax.nn.silu(g)
        sg = spatial_gating(jax.nn.gelu(u).reshape(bsz, seq, SG_GROUPS, SG_GROUP_DIM),
                            jax.nn.gelu(vs).reshape(bsz, seq, SG_GROUPS, SG_GROUP_DIM),
                            sg_w_s[layer], sg_b_s[layer]).reshape(bsz, seq, SG_WIDTH)
        mix = jnp.concatenate([ret, sg], axis=-1) @ w_out[layer]
        x = x + gate1[:, None] * mix

        h2 = rms_norm(x, norm2_w[layer]) * (1 + scale2[:, None]) + shift2[:, None]
        x = x + gate2[:, None] * shared_router_moe(h2, w_router, router_bias, w1[layer], w3[layer], w2[layer])
    return rms_norm(x, final_norm_w)
```

```cpp
#include <hip/hip_runtime.h>
#include <cstdio>
#include <cstdint>

#ifndef MK_N_LAUNCHES
#define MK_N_LAUNCHES 1
#endif
#ifndef MK_CHECK
#define MK_CHECK 0
#endif
#ifndef MK_CHECK_LAYER
#define MK_CHECK_LAYER 0
#endif
#ifndef MK_DUMP
#define MK_DUMP 0
#define MK_DUMP_A 1
#define MK_DUMP_B 2
#endif
#ifndef MK_SIMPLE_GEMM
#define MK_SIMPLE_GEMM 0
#endif

#ifndef PH_MASK
#define PH_MASK 0xFFF
#endif
#define HASK(k) (((PH_MASK) >> (k)) & 1)
#define GAS __attribute__((address_space(1)))
#define LAS __attribute__((address_space(3)))
typedef unsigned short bf16_t;
typedef short bf16x8 __attribute__((ext_vector_type(8)));
typedef short bf16x4 __attribute__((ext_vector_type(4)));
typedef float f32x4 __attribute__((ext_vector_type(4)));
typedef float f32x2 __attribute__((ext_vector_type(2)));
typedef unsigned u32x4 __attribute__((ext_vector_type(4)));
typedef unsigned u32x2 __attribute__((ext_vector_type(2)));

constexpr int NB = 2, SEQ = 16384, D = 2048, NTOK = NB * SEQ;
constexpr int RW = 1024, RH = 4, RD = 256, CH = 128, NCH = SEQ / CH;
constexpr int SGW = 1024, SGG = 8, SGD = 128;
constexpr int INC = 6144;
constexpr int NE = 32, NG = 8, EPG = 4, FF = 512;
constexpr int NBUCK = 48;
constexpr int MAXROWS = 45056;
constexpr int NADA = 6;
constexpr float EPS = 1e-6f;
constexpr int NWAVES = 8, NTHR = 512;

constexpr size_t MiB = 1u << 20;
constexpr size_t WS_CTL = 0, CTL_ZERO_BYTES = 1 * MiB;
constexpr size_t WS_MOD = 1 * MiB;
constexpr size_t WS_WRT = 1 * MiB + 256 * 1024;
constexpr size_t WS_SGW = 1 * MiB + 512 * 1024;
constexpr size_t WS_TOKINFO = 2 * MiB;
constexpr size_t WS_ROW2TOK = 2 * MiB + 512 * 1024;
constexpr size_t WS_ROWGATE = 3 * MiB;
constexpr size_t WS_COS = 4 * MiB, WS_SIN = 20 * MiB, WS_COST = 36 * MiB, WS_SINT = 52 * MiB;
constexpr size_t WS_WIN = 68 * MiB;
constexpr size_t WS_WOUT = 92 * MiB;
constexpr size_t WS_W13 = 100 * MiB;
constexpr size_t WS_W2 = 228 * MiB;
constexpr size_t WS_XB = 292 * MiB;
constexpr size_t WS_HBUF = 548 * MiB;
constexpr size_t WS_PROJ = 676 * MiB;
constexpr size_t WS_Q = WS_PROJ, WS_K = WS_PROJ + 64 * MiB, WS_G = WS_PROJ + 128 * MiB, WS_U = WS_PROJ + 192 * MiB;
constexpr size_t WS_KT = WS_PROJ + 256 * MiB, WS_VT = WS_PROJ + 320 * MiB, WS_VST = WS_PROJ + 384 * MiB;
constexpr size_t WS_H2P = WS_PROJ;
constexpr size_t WS_HH = WS_PROJ + 176 * MiB;
constexpr size_t WS_KVT = 1124 * MiB;
constexpr size_t WS_END = 1252 * MiB;
constexpr int CW_BAR = 4096;
constexpr int CW_CNT = 16384;

constexpr int RING_BYTES = 131072;
constexpr int LDSCTL_OFF = RING_BYTES;
constexpr int TT_OFF = LDSCTL_OFF + 64;
constexpr int LDS_BYTES = 147456;

__device__ __forceinline__ unsigned f2bf(float f) { unsigned u = __builtin_bit_cast(unsigned, f); return (u + 0x7fffu + ((u >> 16) & 1u)) >> 16; }
__device__ __forceinline__ unsigned pk2(float lo, float hi) { return f2bf(lo) | (f2bf(hi) << 16); }
__device__ __forceinline__ float u2f(unsigned u) { return __builtin_bit_cast(float, u); }
__device__ __forceinline__ unsigned f2u(float f) { return __builtin_bit_cast(unsigned, f); }
__device__ __forceinline__ float bflo(unsigned w) { return __builtin_bit_cast(float, w << 16); }
__device__ __forceinline__ float bfhi(unsigned w) { return __builtin_bit_cast(float, w & 0xffff0000u); }
__device__ __forceinline__ float wave_sum(float v) {
#pragma unroll
    for (int o = 1; o < 64; o <<= 1) v += __shfl_xor(v, o);
    return v;
}
__device__ __forceinline__ float sigmoidf_(float x) { return 1.0f / (1.0f + __expf(-x)); }
__device__ __forceinline__ float siluf_(float x) { return x / (1.0f + __expf(-x)); }
__device__ __forceinline__ float gelu_tanh(float x) {
    const float y = 0.7978845608028654f * (x + 0.044715f * x * x * x);
    const float t = 1.0f - 2.0f / (__expf(2.0f * y) + 1.0f);
    return 0.5f * x * (1.0f + t);
}
__device__ __forceinline__ float log2_gamma(int h) { return __log2f(1.0f - exp2f(-5.0f - (float)h)); }

#define XB_TMO      128
#define XB_XCNT(j)  (256  + 64 * (j))
#define XB_XSUB(j)  (1280 + 64 * (j))
#define XB_XGEN(j)  (2304 + 64 * (j))
#define XB_TOP      3328
#define XB_TOPGEN   3392
#define XCD_BAR_WORDS 3456
#define XB_SPIN_CAP (1u << 20)
__device__ __forceinline__ unsigned xb_ld(unsigned* p)              { return __hip_atomic_load(p, __ATOMIC_RELAXED, __HIP_MEMORY_SCOPE_AGENT); }
__device__ __forceinline__ unsigned xb_add(unsigned* p, unsigned v) { return __hip_atomic_fetch_add(p, v, __ATOMIC_RELAXED, __HIP_MEMORY_SCOPE_AGENT); }
__device__ __forceinline__ unsigned xb_xcc_id() { return (unsigned)__builtin_amdgcn_s_getreg((3 << 11) | 20) & 0xFu; }
#define XB_SPIN(cond, bar) do { unsigned _sp = 0; while (cond) { __builtin_amdgcn_s_sleep(1); \
    if ((++_sp & 255u) == 0u) { if (xb_ld(&(bar)[XB_TMO])) break; if (_sp > XB_SPIN_CAP) { atomicAdd(&(bar)[XB_TMO], 1u); break; } } } } while (0)
struct XcdBarrier { unsigned* bar; unsigned x; volatile LAS unsigned* st; };
__device__ __forceinline__ XcdBarrier xcd_barrier_post(unsigned* bar, volatile LAS unsigned* st) {
    XcdBarrier b; b.bar = bar; b.x = xb_xcc_id(); b.st = st;
    if (threadIdx.x == 0) (void)xb_add(&bar[XB_XCNT(b.x)], 1u);
    return b;
}
__device__ __forceinline__ void xcd_barrier_complete(unsigned* bar, unsigned x, unsigned& nloc, unsigned& nx) {
    const unsigned G = gridDim.x * gridDim.y * gridDim.z;
    unsigned sum, cnt, mine, sp = 0u;
    for (;;) {
        sum = 0u; cnt = 0u; mine = 0u;
#pragma unroll
        for (unsigned j = 0; j < 16; ++j) { const unsigned c = xb_ld(&bar[XB_XCNT(j)]); sum += c; cnt += (c > 0u) ? 1u : 0u; mine = (j == x) ? c : mine; }
        if (sum == G) break;
        __builtin_amdgcn_s_sleep(1);
        if ((++sp & 255u) == 0u) { if (xb_ld(&bar[XB_TMO])) break; if (sp > XB_SPIN_CAP) { atomicAdd(&bar[XB_TMO], 1u); break; } }
    }
    nloc = mine > 0u ? mine : 1u; nx = cnt > 0u ? cnt : 1u;
}
__device__ __forceinline__ void xcd_barrier(const XcdBarrier& b) {
    asm volatile("s_waitcnt vmcnt(0)" ::: "memory");
    __syncthreads();
    if (threadIdx.x == 0) {
        unsigned* bar = b.bar;
        __builtin_amdgcn_s_waitcnt(0);
        unsigned nloc = b.st[0], nx = b.st[1];
        if (nloc == 0u) { xcd_barrier_complete(bar, b.x, nloc, nx); b.st[0] = nloc; b.st[1] = nx; }
        const unsigned old = xb_add(&bar[XB_XSUB(b.x)], 1u);
        const unsigned gen = old / nloc;
        if (old + 1u == (gen + 1u) * nloc) {
            __builtin_amdgcn_fence(__ATOMIC_RELEASE, "agent");
            asm volatile("s_waitcnt vmcnt(0)" ::: "memory");
            const unsigned og = xb_add(&bar[XB_TOP], 1u);
            const unsigned tg = og / nx;
            if (og + 1u == (tg + 1u) * nx) xb_add(&bar[XB_TOPGEN], 1u);
            else XB_SPIN(xb_ld(&bar[XB_TOPGEN]) == tg, bar);
            __builtin_amdgcn_fence(__ATOMIC_ACQUIRE, "agent");
            xb_add(&bar[XB_XGEN(b.x)], 1u);
            asm volatile("s_waitcnt vmcnt(0)" ::: "memory");
        } else {
            XB_SPIN(xb_ld(&bar[XB_XGEN(b.x)]) == gen, bar);
            __builtin_amdgcn_fence(__ATOMIC_ACQUIRE, "agent");
            asm volatile("s_waitcnt vmcnt(0)" ::: "memory");
        }
    }
    __syncthreads();
}

namespace pg8 {
constexpr int BM = 256, BK = 64, HALF = 128, HTB = HALF * BK * 2, STAGE_BYTES = 8 * HTB;
__host__ __device__ __forceinline__ int lds_byte(int r, int c) { const int st = (r >> 4) * 2 + (c >> 5), rr = r & 15, cc = c & 31, ob = rr * 64 + cc * 2; return st * 1024 + (ob ^ (((ob >> 9) & 1) << 5)); }
__host__ __device__ __forceinline__ void stage_rc(int b, int& R, int& C) { const int st = b / 1024, sb = b % 1024, swz = sb ^ (((sb >> 9) & 1) << 5); R = (st >> 1) * 16 + swz / 64; C = (st & 1) * 32 + (swz % 64) / 2; }
__host__ __device__ __forceinline__ int perm32(int rho) { const int n = rho >> 4, i = rho & 15; return 8 * (i >> 2) + 4 * n + (i & 3); }

struct Unit { const char* A; const char* B0; const char* B1; int pm, pn, aux; };

template <class Epi, class Sched, bool KSPLIT>
__device__ __forceinline__ void gemm_phase_simple(const int tid, const int K, const int ldA, const int ldB, const int ks, const Sched& S, const Epi& E) {
    const int wid = __builtin_amdgcn_readfirstlane(tid >> 6), lane = tid & 63, wr = wid >> 2, wc = wid & 3, fr = lane & 15, fq = lane >> 4;
    const int nt = K / BK;
    Unit cur;
    for (int ui = 0; S.next(ui, cur); ++ui) {
        f32x4 acc[2][2][4][2];
#pragma unroll
        for (int a = 0; a < 2; ++a)
#pragma unroll
            for (int b = 0; b < 2; ++b)
#pragma unroll
                for (int m = 0; m < 4; ++m)
#pragma unroll
                    for (int n = 0; n < 2; ++n) acc[a][b][m][n] = (f32x4){0.f, 0.f, 0.f, 0.f};
        for (int tt = 0; tt < nt; ++tt) {
            const char* ap = cur.A + (size_t)tt * 128;
            const char* bp = (KSPLIT && tt >= ks) ? cur.B1 + (size_t)(tt - ks) * 128 : cur.B0 + (size_t)tt * 128;
#pragma unroll
            for (int kk = 0; kk < 2; ++kk) {
                bf16x8 Bf[2][2];
#pragma unroll
                for (int bj = 0; bj < 2; ++bj)
#pragma unroll
                    for (int n = 0; n < 2; ++n) { const int rs = Epi::PERM ? perm32(16 * n + fr) : 16 * n + fr;
                        Bf[bj][n] = *(const bf16x8*)(bp + (unsigned)(((bj * 128 + wc * 32 + rs) * ldB + kk * 32 + fq * 8) * 2)); }
#pragma unroll
                for (int ai = 0; ai < 2; ++ai) {
                    bf16x8 Af[4];
#pragma unroll
                    for (int m = 0; m < 4; ++m) Af[m] = *(const bf16x8*)(ap + (unsigned)(((ai * 128 + wr * 64 + m * 16 + fr) * ldA + kk * 32 + fq * 8) * 2));
#pragma unroll
                    for (int bj = 0; bj < 2; ++bj)
#pragma unroll
                        for (int m = 0; m < 4; ++m)
#pragma unroll
                            for (int n = 0; n < 2; ++n) acc[ai][bj][m][n] = __builtin_amdgcn_mfma_f32_16x16x32_bf16(Bf[bj][n], Af[m], acc[ai][bj][m][n], 0, 0, 0);
                    asm volatile("" ::: "memory");
                }
            }
        }
        E(acc, cur, wr, wc, fr, fq);
    }
}

template <class Epi, class Sched, bool KSPLIT>
__device__ __forceinline__ void gemm_phase_pipe(LAS unsigned char* lds, const int tid, const int K, const int ldA, const int ldB, const int ks, const Sched& S, const Epi& E) {
    const int wid = __builtin_amdgcn_readfirstlane(tid >> 6), lane = tid & 63, wr = wid >> 2, wc = wid & 3, fr = lane & 15, fq = lane >> 4;
    const int nt = K / BK;
    unsigned voffA[2], voffB[2];
#pragma unroll
    for (int i = 0; i < 2; ++i) { int R, C; stage_rc(tid * 16 + i * 8192, R, C); const int Rb = Epi::PERM ? ((R & ~31) + perm32(R & 31)) : R;
        voffA[i] = (unsigned)(R * ldA + C) * 2u; voffB[i] = (unsigned)(Rb * ldB + C) * 2u; }
    const size_t kstep = (size_t)(BK * 2);
    const size_t hstepA = (size_t)HALF * ldA * 2, hstepB = (size_t)HALF * ldB * 2;
    const unsigned ldsw = (unsigned)wid * 1024u;
    const int aoff = lds_byte(wr * 64 + fr, fq * 8), boff = lds_byte(wc * 32 + fr, fq * 8);
#define PG8_SA(b, h) (((b) * 2 + (h)) * HTB)
#define PG8_SB(b, h) ((4 + (b) * 2 + (h)) * HTB)
#define PG8_STAGE(bufoff, gbase, voff) do { _Pragma("unroll") for (int _i = 0; _i < 2; ++_i) \
        __builtin_amdgcn_global_load_lds((const unsigned*)((const char*)(gbase) + (voff)[_i]), (LAS unsigned*)(lds + (bufoff) + ldsw + _i * 8192), 16, 0, 0); } while (0)
#define PG8_LDA(dst, b, h) do { _Pragma("unroll") for (int m = 0; m < 4; ++m) _Pragma("unroll") for (int k = 0; k < 2; ++k) dst[m][k] = *(const LAS bf16x8*)(lds + PG8_SA(b, h) + aoff + m * 2048 + k * 1024); } while (0)
#define PG8_LDB(dst, b, h) do { _Pragma("unroll") for (int n = 0; n < 2; ++n) _Pragma("unroll") for (int k = 0; k < 2; ++k) dst[n][k] = *(const LAS bf16x8*)(lds + PG8_SB(b, h) + boff + n * 2048 + k * 1024); } while (0)
#define PG8_MMA(ai, bj, At, Bt) do { __builtin_amdgcn_s_setprio(1); _Pragma("unroll") for (int m = 0; m < 4; ++m) _Pragma("unroll") for (int n = 0; n < 2; ++n) _Pragma("unroll") for (int k = 0; k < 2; ++k) \
        acc[ai][bj][m][n] = __builtin_amdgcn_mfma_f32_16x16x32_bf16(Bt[n][k], At[m][k], acc[ai][bj][m][n], 0, 0, 0); __builtin_amdgcn_s_setprio(0); } while (0)
#define PG8_WAIT_V(n) asm volatile("s_waitcnt vmcnt(" #n ")" ::: "memory")
#define PG8_WAIT_L(n) asm volatile("s_waitcnt lgkmcnt(" #n ")" ::: "memory")
#define PG8_BAR __builtin_amdgcn_s_barrier()
#define PG8_SCHED __builtin_amdgcn_sched_barrier(0)
#define PG8_BPTR(u, tt) ((KSPLIT && (tt) >= ks) ? (u).B1 + (size_t)((tt) - ks) * kstep : (u).B0 + (size_t)(tt) * kstep)
    Unit cur, nxt; int ui = 0;
    if (!S.next(0, cur)) return;
    f32x4 acc[2][2][4][2];
#pragma unroll
    for (int a = 0; a < 2; ++a)
#pragma unroll
        for (int b = 0; b < 2; ++b)
#pragma unroll
            for (int m = 0; m < 4; ++m)
#pragma unroll
                for (int n = 0; n < 2; ++n) acc[a][b][m][n] = (f32x4){0.f, 0.f, 0.f, 0.f};
    bf16x8 At[4][2], B0[2][2], B1[2][2];
    {
        const char* cA = cur.A; const char* cB = cur.B0;
        PG8_STAGE(PG8_SB(0, 0), cB, voffB); PG8_STAGE(PG8_SA(0, 0), cA, voffA); PG8_STAGE(PG8_SB(0, 1), cB + hstepB, voffB); PG8_STAGE(PG8_SA(0, 1), cA + hstepA, voffA);
        if (wr == 1) PG8_BAR;
        PG8_WAIT_V(4); PG8_BAR;
        PG8_STAGE(PG8_SB(1, 0), cB + kstep, voffB); PG8_STAGE(PG8_SA(1, 0), cA + kstep, voffA); PG8_STAGE(PG8_SB(1, 1), cB + hstepB + kstep, voffB);
        PG8_WAIT_V(6); PG8_BAR;
    }
    for (;;) {
        const bool has_next = S.next(ui + 1, nxt);
        if (!has_next) nxt = cur;
        for (int t = 0; t < nt; t += 2) {
            const bool last = (t == nt - 2);
            const char* a1 = cur.A + (size_t)(t + 1) * kstep;
            const char* a2 = last ? nxt.A : cur.A + (size_t)(t + 2) * kstep;
            const char* b2 = last ? nxt.B0 : PG8_BPTR(cur, t + 2);
            const char* a3 = a2 + kstep; const char* b3 = b2 + kstep;
            PG8_LDB(B0, 0, 0); PG8_SCHED; PG8_LDA(At, 0, 0); PG8_STAGE(PG8_SA(1, 1), a1 + hstepA, voffA);
            PG8_WAIT_L(8); PG8_BAR; PG8_WAIT_L(0); PG8_MMA(0, 0, At, B0); PG8_BAR; PG8_SCHED;
            PG8_LDB(B1, 0, 1); PG8_STAGE(PG8_SB(0, 0), b2, voffB);
            PG8_BAR; PG8_WAIT_L(0); PG8_MMA(0, 1, At, B1); PG8_BAR;
            PG8_LDA(At, 0, 1); PG8_STAGE(PG8_SA(0, 0), a2, voffA);
            PG8_BAR; PG8_WAIT_L(0); PG8_MMA(1, 0, At, B0); PG8_BAR; PG8_SCHED;
            PG8_STAGE(PG8_SB(0, 1), b2 + hstepB, voffB);
            PG8_WAIT_V(6); PG8_BAR; PG8_MMA(1, 1, At, B1); PG8_BAR;
            PG8_LDB(B0, 1, 0); PG8_SCHED; PG8_LDA(At, 1, 0); PG8_STAGE(PG8_SA(0, 1), a2 + hstepA, voffA);
            PG8_WAIT_L(8); PG8_BAR; PG8_WAIT_L(0); PG8_MMA(0, 0, At, B0); PG8_BAR; PG8_SCHED;
            PG8_LDB(B1, 1, 1); PG8_STAGE(PG8_SB(1, 0), b3, voffB);
            PG8_BAR; PG8_WAIT_L(0); PG8_MMA(0, 1, At, B1); PG8_BAR;
            PG8_LDA(At, 1, 1); PG8_STAGE(PG8_SA(1, 0), a3, voffA);
            PG8_BAR; PG8_WAIT_L(0); PG8_MMA(1, 0, At, B0); PG8_BAR; PG8_SCHED;
            PG8_STAGE(PG8_SB(1, 1), b3 + hstepB, voffB);
            PG8_WAIT_V(6); PG8_BAR; PG8_MMA(1, 1, At, B1); PG8_BAR;
        }
        E(acc, cur, wr, wc, fr, fq);
        if (!has_next) break;
#pragma unroll
        for (int a = 0; a < 2; ++a)
#pragma unroll
            for (int b = 0; b < 2; ++b)
#pragma unroll
                for (int m = 0; m < 4; ++m)
#pragma unroll
                    for (int n = 0; n < 2; ++n) acc[a][b][m][n] = (f32x4){0.f, 0.f, 0.f, 0.f};
        cur = nxt; ++ui;
    }
    PG8_WAIT_V(0);
    if (wr == 0) PG8_BAR;
    PG8_BAR;
#undef PG8_SA
#undef PG8_SB
#undef PG8_STAGE
#undef PG8_LDA
#undef PG8_LDB
#undef PG8_MMA
#undef PG8_WAIT_V
#undef PG8_WAIT_L
#undef PG8_BAR
#undef PG8_SCHED
#undef PG8_BPTR
}
template <class Epi, class Sched, bool KSPLIT>
__device__ __forceinline__ void gemm_phase(LAS unsigned char* lds, const int tid, const int Kc, const int ldA, const int ldB, const int ks, const Sched& S, const Epi& E) {
    int K = Kc; asm volatile("" : "+s"(K));
#if MK_SIMPLE_GEMM
    gemm_phase_simple<Epi, Sched, KSPLIT>(tid, K, ldA, ldB, ks, S, E);
    __syncthreads();
#else
    gemm_phase_pipe<Epi, Sched, KSPLIT>(lds, tid, K, ldA, ldB, ks, S, E);
#endif
}
}
using pg8::Unit;

__device__ __forceinline__ int vcu_of(int bx, int G) { return (G % 8 == 0) ? (bx % 8) * (G / 8) + bx / 8 : bx; }

struct SchedProj {
    const char* A; const char* B; int G, c;
    __device__ __forceinline__ bool next(int i, Unit& u) const {
        const int L = i * G + c; if (L >= 2048) return false;
        const int blk = L >> 5, w = L & 31, pml = w & 7, pnl = w >> 3, bm = blk & 15, sel = blk >> 4;
        const int pm = bm * 8 + pml, ct = (sel == 0 ? 0 : sel == 1 ? 4 : sel == 2 ? 12 : 16) + pnl;
        u.A = A + (size_t)pm * 256 * D * 2; u.B0 = B + (size_t)ct * 256 * D * 2; u.B1 = u.B0; u.pm = pm; u.pn = pnl; u.aux = sel; return true;
    }
};
struct SchedProjT {
    const char* W; const char* Hn; int G, c;
    __device__ __forceinline__ bool next(int i, Unit& u) const {
        const int L = i * G + c; if (L >= 1536) return false;
        const int blk = L >> 5, w = L & 31, ptl = w & 7, pfl = w >> 3, bt = blk & 15, type = blk >> 4;
        const int pt = bt * 8 + ptl, frow = (type == 0 ? 1024 : type == 1 ? 2048 : 5120) + 256 * pfl;
        u.A = W + (size_t)frow * D * 2; u.B0 = Hn + (size_t)pt * 256 * D * 2; u.B1 = u.B0; u.pm = pfl; u.pn = pt; u.aux = type; return true;
    }
};
struct SchedKV {
    const char* VT; const char* KT; int G, c;
    __device__ __forceinline__ bool next(int i, Unit& u) const {
        const int L = i * G + c; if (L >= 1024) return false;
        const int ch = L & 127, h = (L >> 7) & 3, b = L >> 9;
        const size_t off = ((size_t)(h * 256) * NTOK + (size_t)b * SEQ + (size_t)ch * CH) * 2;
        u.A = VT + off; u.B0 = KT + off; u.B1 = u.B0; u.pm = L; u.pn = 0; u.aux = 0; return true;
    }
};
struct SchedOut {
    const char* A; const char* B; int G, c;
    __device__ __forceinline__ bool next(int i, Unit& u) const {
        const int L = i * G + c; if (L >= 1024) return false;
        const int blk = L >> 5, w = L & 31, pml = w & 7, pnl = w >> 3, bm = blk & 15, bn = blk >> 4;
        const int pm = bm * 8 + pml, pn = bn * 4 + pnl;
        u.A = A + (size_t)pm * 256 * D * 2; u.B0 = B + (size_t)pn * 256 * D * 2; u.B1 = u.B0; u.pm = pm; u.pn = pn; u.aux = 0; return true;
    }
};
__device__ __forceinline__ void bucket_experts(int bucket, int& elo, int& ehi) {
    const int gq = bucket / 6, p = bucket - gq * 6; int lo, hi;
    if (p < 3) { lo = 0; hi = p + 1; } else if (p < 5) { lo = 1; hi = p - 1; } else { lo = 2; hi = 3; }
    elo = gq * 4 + lo; ehi = gq * 4 + hi;
}
struct SchedUp {
    const char* A; const char* W13; const LAS int* tt; int G, c;
    __device__ __forceinline__ bool next(int i, Unit& u) const {
        const int L = i * G + c; const int T = __builtin_amdgcn_readfirstlane(tt[0]); if (L >= T * 8) return false;
        const int tile = L >> 3, pn = L & 7, bucket = __builtin_amdgcn_readfirstlane(tt[64 + tile]); int elo, ehi; bucket_experts(bucket, elo, ehi);
        const int e = (pn >> 2) ? ehi : elo, jb = pn & 3;
        u.A = A + (size_t)tile * 256 * D * 2; u.B0 = W13 + ((size_t)e * 1024 + (size_t)jb * 256) * D * 2; u.B1 = u.B0; u.pm = tile; u.pn = pn; u.aux = 0; return true;
    }
};
struct SchedDown {
    const char* A; const char* W2; const LAS int* tt; int G, c;
    __device__ __forceinline__ bool next(int i, Unit& u) const {
        const int L = i * G + c; const int T = __builtin_amdgcn_readfirstlane(tt[0]); if (L >= T * 8) return false;
        const int tile = L >> 3, pn = L & 7, bucket = __builtin_amdgcn_readfirstlane(tt[64 + tile]); int elo, ehi; bucket_experts(bucket, elo, ehi);
        u.A = A + (size_t)tile * 256 * 1024 * 2; u.B0 = W2 + ((size_t)elo * 2048 + (size_t)pn * 256) * FF * 2; u.B1 = W2 + ((size_t)ehi * 2048 + (size_t)pn * 256) * FF * 2;
        u.pm = tile; u.pn = pn; u.aux = 0; return true;
    }
};

struct EpiProj {
    static constexpr bool PERM = true;
    unsigned char* ws;
    __device__ __forceinline__ void operator()(const f32x4 (&acc)[2][2][4][2], const Unit& u, int wr, int wc, int fr, int fq) const {
        const int sel = u.aux;
        bf16_t* O = (bf16_t*)(ws + WS_Q + (size_t)sel * (64 * MiB));
        const float* cosb = (const float*)(ws + WS_COS); const float* sinb = (const float*)(ws + WS_SIN);
        const int j0 = wc * 32 + 8 * fq;
#pragma unroll
        for (int ai = 0; ai < 2; ++ai)
#pragma unroll
            for (int m = 0; m < 4; ++m) {
                const int row = u.pm * 256 + ai * 128 + wr * 64 + m * 16 + fr;
                bf16_t* orow = O + (size_t)row * 1024 + u.pn * 256 + j0;
                if (sel < 2) {
                    const float sc = sel == 1 ? 0.0625f : 1.0f;
                    const f32x4 c0 = *(const f32x4*)(cosb + (size_t)row * 128 + j0), c1 = *(const f32x4*)(cosb + (size_t)row * 128 + j0 + 4);
                    const f32x4 s0 = *(const f32x4*)(sinb + (size_t)row * 128 + j0), s1 = *(const f32x4*)(sinb + (size_t)row * 128 + j0 + 4);
                    const f32x4 x10 = acc[ai][0][m][0], x11 = acc[ai][0][m][1], x20 = acc[ai][1][m][0], x21 = acc[ai][1][m][1];
                    const f32x4 o10 = (x10 * c0 - x20 * s0) * sc, o11 = (x11 * c1 - x21 * s1) * sc, o20 = (x20 * c0 + x10 * s0) * sc, o21 = (x21 * c1 + x11 * s1) * sc;
                    u32x4 w; w.x = pk2(o10[0], o10[1]); w.y = pk2(o10[2], o10[3]); w.z = pk2(o11[0], o11[1]); w.w = pk2(o11[2], o11[3]);
                    *(u32x4*)(orow) = w;
                    w.x = pk2(o20[0], o20[1]); w.y = pk2(o20[2], o20[3]); w.z = pk2(o21[0], o21[1]); w.w = pk2(o21[2], o21[3]);
                    *(u32x4*)(orow + 128) = w;
                } else {
#pragma unroll
                    for (int bj = 0; bj < 2; ++bj) { f32x4 v0 = acc[ai][bj][m][0], v1 = acc[ai][bj][m][1];
#pragma unroll
                        for (int i = 0; i < 4; ++i) { v0[i] = sel == 2 ? siluf_(v0[i]) : gelu_tanh(v0[i]); v1[i] = sel == 2 ? siluf_(v1[i]) : gelu_tanh(v1[i]); }
                        u32x4 w; w.x = pk2(v0[0], v0[1]); w.y = pk2(v0[2], v0[3]); w.z = pk2(v1[0], v1[1]); w.w = pk2(v1[2], v1[3]);
                        *(u32x4*)(orow + bj * 128) = w; }
                }
                asm volatile("" ::: "memory");
            }
    }
};
struct EpiProjT {
    static constexpr bool PERM = true;
    unsigned char* ws;
    __device__ __forceinline__ void operator()(const f32x4 (&acc)[2][2][4][2], const Unit& u, int wr, int wc, int fr, int fq) const {
        const int type = u.aux;
        bf16_t* O = (bf16_t*)(ws + WS_KT + (size_t)type * (64 * MiB));
        const float* cosT = (const float*)(ws + WS_COST); const float* sinT = (const float*)(ws + WS_SINT);
        const int t0 = u.pn * 256 + wc * 32 + 8 * fq;
        if (type == 0) {
            const float lg = log2_gamma(u.pm), rg = __builtin_amdgcn_exp2f(-lg);
#pragma unroll
            for (int m = 0; m < 4; ++m) {
                const int j = wr * 64 + m * 16 + fr;
#pragma unroll
                for (int bj = 0; bj < 2; ++bj) {
                    const int tok = t0 + bj * 128;
                    u32x4 w1, w2;
#pragma unroll
                    for (int n = 0; n < 2; ++n) {
                        const f32x4 c0 = *(const f32x4*)(cosT + (size_t)j * NTOK + tok + 4 * n), s0 = *(const f32x4*)(sinT + (size_t)j * NTOK + tok + 4 * n);
                        f32x4 d0; d0[0] = 0.0625f * __builtin_amdgcn_exp2f(lg * (float)(127 - ((tok + 4 * n) & 127)));
                        d0[1] = d0[0] * rg; d0[2] = d0[1] * rg; d0[3] = d0[2] * rg;
                        const f32x4 x1 = acc[0][bj][m][n], x2 = acc[1][bj][m][n];
                        const f32x4 o1 = (x1 * c0 - x2 * s0) * d0, o2 = (x2 * c0 + x1 * s0) * d0;
                        if (n == 0) { w1.x = pk2(o1[0], o1[1]); w1.y = pk2(o1[2], o1[3]); w2.x = pk2(o2[0], o2[1]); w2.y = pk2(o2[2], o2[3]); }
                        else        { w1.z = pk2(o1[0], o1[1]); w1.w = pk2(o1[2], o1[3]); w2.z = pk2(o2[0], o2[1]); w2.w = pk2(o2[2], o2[3]); }
                        asm volatile("" ::: "memory");
                    }
                    *(u32x4*)(O + (size_t)(u.pm * 256 + j) * NTOK + tok) = w1;
                    *(u32x4*)(O + (size_t)(u.pm * 256 + 128 + j) * NTOK + tok) = w2;
                    asm volatile("" ::: "memory");
                }
            }
        } else {
#pragma unroll
            for (int ai = 0; ai < 2; ++ai)
#pragma unroll
                for (int m = 0; m < 4; ++m) {
                    const int f = u.pm * 256 + ai * 128 + wr * 64 + m * 16 + fr;
#pragma unroll
                    for (int bj = 0; bj < 2; ++bj) { f32x4 v0 = acc[ai][bj][m][0], v1 = acc[ai][bj][m][1];
                        if (type == 2) {
#pragma unroll
                            for (int i = 0; i < 4; ++i) { v0[i] = gelu_tanh(v0[i]); v1[i] = gelu_tanh(v1[i]); } }
                        u32x4 w; w.x = pk2(v0[0], v0[1]); w.y = pk2(v0[2], v0[3]); w.z = pk2(v1[0], v1[1]); w.w = pk2(v1[2], v1[3]);
                        *(u32x4*)(O + (size_t)f * NTOK + t0 + bj * 128) = w; }
                }
        }
    }
};
struct EpiKV {
    static constexpr bool PERM = true;
    bf16_t* O;
    __device__ __forceinline__ void operator()(const f32x4 (&acc)[2][2][4][2], const Unit& u, int wr, int wc, int fr, int fq) const {
        bf16_t* base = O + (size_t)u.pm * 65536;
#pragma unroll
        for (int ai = 0; ai < 2; ++ai)
#pragma unroll
            for (int m = 0; m < 4; ++m) { bf16_t* rowp = base + (size_t)(ai * 128 + wr * 64 + m * 16 + fr) * 256 + wc * 32 + 8 * fq;
#pragma unroll
                for (int bj = 0; bj < 2; ++bj) { const f32x4 v0 = acc[ai][bj][m][0], v1 = acc[ai][bj][m][1];
                    u32x4 w; w.x = pk2(v0[0], v0[1]); w.y = pk2(v0[2], v0[3]); w.z = pk2(v1[0], v1[1]); w.w = pk2(v1[2], v1[3]);
                    *(u32x4*)(rowp + bj * 128) = w; } }
    }
};
struct EpiOut {
    static constexpr bool PERM = false;
    const float* xi; float* xo; const float* gate;
    __device__ __forceinline__ void operator()(const f32x4 (&acc)[2][2][4][2], const Unit& u, int wr, int wc, int fr, int fq) const {
        const int b = (u.pm * 256) >> 14; const float* gb = gate + (size_t)b * 12288;
        const int col0 = u.pn * 256 + wc * 32 + 4 * fq;
        f32x4 gv[2][2];
#pragma unroll
        for (int bj = 0; bj < 2; ++bj)
#pragma unroll
            for (int n = 0; n < 2; ++n) gv[bj][n] = *(const f32x4*)(gb + col0 + bj * 128 + n * 16);
#pragma unroll
        for (int ai = 0; ai < 2; ++ai)
#pragma unroll
            for (int m = 0; m < 4; ++m) { const size_t off = (size_t)(u.pm * 256 + ai * 128 + wr * 64 + m * 16 + fr) * D + col0;
#pragma unroll
                for (int bj = 0; bj < 2; ++bj)
#pragma unroll
                    for (int n = 0; n < 2; ++n) { const f32x4 xv = *(const f32x4*)(xi + off + bj * 128 + n * 16);
                        *(f32x4*)(xo + off + bj * 128 + n * 16) = xv + gv[bj][n] * acc[ai][bj][m][n]; }
                asm volatile("" ::: "memory"); }
    }
};
struct EpiUp {
    static constexpr bool PERM = true;
    bf16_t* HH; const float* rowgate;
    __device__ __forceinline__ void operator()(const f32x4 (&acc)[2][2][4][2], const Unit& u, int wr, int wc, int fr, int fq) const {
        const int es = u.pn >> 2, jb = u.pn & 3;
#pragma unroll
        for (int ai = 0; ai < 2; ++ai)
#pragma unroll
            for (int m = 0; m < 4; ++m) { const int row = u.pm * 256 + ai * 128 + wr * 64 + m * 16 + fr;
                const float g = rowgate[(size_t)row * 2 + es];
                f32x4 h0, h1;
#pragma unroll
                for (int i = 0; i < 4; ++i) { h0[i] = siluf_(acc[ai][0][m][0][i]) * acc[ai][1][m][0][i] * g; h1[i] = siluf_(acc[ai][0][m][1][i]) * acc[ai][1][m][1][i] * g; }
                u32x4 w; w.x = pk2(h0[0], h0[1]); w.y = pk2(h0[2], h0[3]); w.z = pk2(h1[0], h1[1]); w.w = pk2(h1[2], h1[3]);
                *(u32x4*)(HH + (size_t)row * 1024 + es * 512 + jb * 128 + wc * 32 + 8 * fq) = w; }
    }
};
struct EpiDown {
    static constexpr bool PERM = false;
    const float* xi; float* xo; const float* gate; const int* row2tok;
    __device__ __forceinline__ void operator()(const f32x4 (&acc)[2][2][4][2], const Unit& u, int wr, int wc, int fr, int fq) const {
        const int col0 = u.pn * 256 + wc * 32 + 4 * fq;
#pragma unroll
        for (int ai = 0; ai < 2; ++ai)
#pragma unroll
            for (int m = 0; m < 4; ++m) { const int row = u.pm * 256 + ai * 128 + wr * 64 + m * 16 + fr; const int tok = row2tok[row];
                if (tok >= 0) { const float* gb = gate + (size_t)(tok >> 14) * 12288; const size_t off = (size_t)tok * D + col0;
#pragma unroll
                    for (int bj = 0; bj < 2; ++bj)
#pragma unroll
                        for (int n = 0; n < 2; ++n) { const f32x4 xv = *(const f32x4*)(xi + off + bj * 128 + n * 16); const f32x4 gv = *(const f32x4*)(gb + col0 + bj * 128 + n * 16);
                            *(f32x4*)(xo + off + bj * 128 + n * 16) = xv + gv * acc[ai][bj][m][n]; } }
                asm volatile("" ::: "memory"); }
    }
};

struct Args { const void* in[18]; float* out; unsigned char* ws; int ph_lo, ph_hi, li, pad; };
enum { I_X = 0, I_C, I_POS, I_WADA, I_BADA, I_N1W, I_N2W, I_WIN, I_WOUT, I_RNW, I_SGW, I_SGB, I_WR, I_RB, I_W1, I_W3, I_W2, I_FNW };

struct Frame {
    LAS unsigned char* lds; int tid, lane, wave, G, vcu; unsigned char* ws;
};

__device__ __forceinline__ void transpose_item(const float* W, int ldw, int k0, int n0, bf16_t* dst, int ldd, LAS float* scr, int lane) {
#pragma unroll 8
    for (int i = 0; i < 32; ++i) { const int kk = 2 * i + (lane >> 5); scr[kk * 33 + (lane & 31)] = W[(size_t)(k0 + kk) * ldw + n0 + (lane & 31)]; }
    asm volatile("s_waitcnt lgkmcnt(0)" ::: "memory");
    const int c = lane & 7;
#pragma unroll
    for (int j = 0; j < 4; ++j) { const int n = (lane >> 3) + 8 * j; const LAS float* s = scr + (8 * c) * 33 + n;
        u32x4 o; o.x = pk2(s[0 * 33], s[1 * 33]); o.y = pk2(s[2 * 33], s[3 * 33]); o.z = pk2(s[4 * 33], s[5 * 33]); o.w = pk2(s[6 * 33], s[7 * 33]);
        *(u32x4*)(dst + (size_t)n * ldd + k0 + 8 * c) = o; }
    asm volatile("s_waitcnt lgkmcnt(0)" ::: "memory");
}
__device__ __forceinline__ void convert_weights(Frame& F, const Args& a, int layer) {
    LAS float* scr = (LAS float*)(F.lds + F.wave * 16384);
    const int gw = F.vcu * NWAVES + F.wave, NGW = F.G * NWAVES;
    const float* w_in = (const float*)a.in[I_WIN] + (size_t)layer * D * INC;
    const float* w_out = (const float*)a.in[I_WOUT] + (size_t)layer * D * D;
    const float* w1 = (const float*)a.in[I_W1] + (size_t)layer * NE * D * FF;
    const float* w3 = (const float*)a.in[I_W3] + (size_t)layer * NE * D * FF;
    const float* w2 = (const float*)a.in[I_W2] + (size_t)layer * NE * FF * D;
    bf16_t* win_t = (bf16_t*)(F.ws + WS_WIN); bf16_t* wout_t = (bf16_t*)(F.ws + WS_WOUT); bf16_t* w13_t = (bf16_t*)(F.ws + WS_W13); bf16_t* w2_t = (bf16_t*)(F.ws + WS_W2);
    constexpr int I_IN = (D / 64) * (INC / 32), I_OUT = (D / 64) * (D / 32), I_E13 = (D / 64) * (FF / 32), I_E2 = (FF / 64) * (D / 32);
    constexpr int NIT = I_IN + I_OUT + 2 * NE * I_E13 + NE * I_E2;
    for (int it = gw; it < NIT; it += NGW) {
        int r = it;
        if (r < I_IN) { const int nb = INC / 32, kb = r / nb, n0 = (r % nb) * 32; transpose_item(w_in, INC, kb * 64, n0, win_t + (size_t)n0 * D, D, scr, F.lane); continue; } r -= I_IN;
        if (r < I_OUT) { const int nb = D / 32, kb = r / nb, n0 = (r % nb) * 32; transpose_item(w_out, D, kb * 64, n0, wout_t + (size_t)n0 * D, D, scr, F.lane); continue; } r -= I_OUT;
        if (r < 2 * NE * I_E13) { const int which = r / (NE * I_E13); r -= which * NE * I_E13; const int e = r / I_E13; r -= e * I_E13;
            const int nb = FF / 32, kb = r / nb, n0 = (r % nb) * 32; const int drow = e * 1024 + (n0 >> 7) * 256 + which * 128 + (n0 & 127);
            transpose_item((which ? w3 : w1) + (size_t)e * D * FF, FF, kb * 64, n0, w13_t + (size_t)drow * D, D, scr, F.lane); continue; } r -= 2 * NE * I_E13;
        { const int e = r / I_E2; r -= e * I_E2; const int nb = D / 32, kb = r / nb, n0 = (r % nb) * 32;
            transpose_item(w2 + (size_t)e * FF * D, D, kb * 64, n0, w2_t + ((size_t)e * 2048 + n0) * FF, FF, scr, F.lane); }
    }
}
__device__ __forceinline__ void p0_prologue(Frame& F, const Args& a) {
    const int gt = F.vcu * NTHR + F.tid, NGT = F.G * NTHR;
    { const int* pos = (const int*)a.in[I_POS]; float* cosb = (float*)(F.ws + WS_COS); float* sinb = (float*)(F.ws + WS_SIN); float* cosT = (float*)(F.ws + WS_COST); float* sinT = (float*)(F.ws + WS_SINT);
      for (int idx = gt; idx < NTOK * 128; idx += NGT) { const int tok = idx >> 7, j = idx & 127;
          const float inv = exp2f(-(float)j * (13.287712379549449f / 128.0f));
          const double rev = (double)pos[tok] * (double)inv * 0.15915494309189535; const float fr = (float)(rev - __builtin_rint(rev));
          cosb[idx] = __builtin_amdgcn_cosf(fr); sinb[idx] = __builtin_amdgcn_sinf(fr); }
      for (int idx = gt; idx < NTOK * 128; idx += NGT) { const int j = idx >> 15, tok = idx & (NTOK - 1);
          const float inv = exp2f(-(float)j * (13.287712379549449f / 128.0f));
          const double rev = (double)pos[tok] * (double)inv * 0.15915494309189535; const float fr = (float)(rev - __builtin_rint(rev));
          cosT[idx] = __builtin_amdgcn_cosf(fr); sinT[idx] = __builtin_amdgcn_sinf(fr); } }
    { const float* wr = (const float*)a.in[I_WR]; bf16_t* wrt = (bf16_t*)(F.ws + WS_WRT);
      for (int idx = gt; idx < NE * D; idx += NGT) { const int e = idx >> 11, k = idx & 2047; wrt[idx] = (bf16_t)f2bf(wr[k * NE + e]); }
      const float* sw = (const float*)a.in[I_SGW]; bf16_t* swb = (bf16_t*)(F.ws + WS_SGW);
      for (int idx = gt; idx < 2 * SGG * CH * CH; idx += NGT) { const int m = idx & 127, n = (idx >> 7) & 127; swb[idx] = (m <= n) ? (bf16_t)f2bf(sw[idx]) : (bf16_t)0; } }
    { LAS float* cact = (LAS float*)F.lds; LAS float* red = (LAS float*)(F.lds + 16384);
      const float* cc = (const float*)a.in[I_C];
      for (int i = F.tid; i < NB * D; i += NTHR) cact[i] = siluf_(cc[i]);
      __syncthreads();
      for (int cb = F.vcu; cb < 256; cb += F.G) {
          const int col0 = cb * 96, layer = col0 / 12288, cl0 = col0 - layer * 12288;
          const float* wa = (const float*)a.in[I_WADA] + (size_t)layer * D * 12288;
          if (F.tid < 384) { const int cg = F.tid % 24, kp = F.tid / 24; f32x4 s0 = {0.f, 0.f, 0.f, 0.f}, s1 = {0.f, 0.f, 0.f, 0.f};
#pragma unroll 8
              for (int k = kp * 128; k < kp * 128 + 128; ++k) { const f32x4 w = *(const f32x4*)(wa + (size_t)k * 12288 + cl0 + 4 * cg); s0 += w * cact[k]; s1 += w * cact[D + k]; }
              *(LAS f32x4*)(red + ((kp * 24 + cg) * 2 + 0) * 4) = s0; *(LAS f32x4*)(red + ((kp * 24 + cg) * 2 + 1) * 4) = s1; }
          __syncthreads();
          if (F.tid < 192) { const int i = F.tid & 3, b = (F.tid >> 2) & 1, cg = F.tid >> 3; float s = 0.f;
#pragma unroll
              for (int kp = 0; kp < 16; ++kp) s += red[((kp * 24 + cg) * 2 + b) * 4 + i];
              const int cl = cl0 + 4 * cg + i; s += ((const float*)a.in[I_BADA])[layer * 12288 + cl];
              ((float*)(F.ws + WS_MOD))[(size_t)(layer * 2 + b) * 12288 + cl] = s; }
          __syncthreads();
      } }
    convert_weights(F, a, 0);
}

template <bool FINAL>
__device__ __forceinline__ void p_norm(Frame& F, const float* x, const float* w, const float* modl  , int shift_off, int scale_off, bf16_t* outb, float* outf) {
    const int gw = F.vcu * NWAVES + F.wave, NGW = F.G * NWAVES;
    for (int row = gw; row < NTOK; row += NGW) {
        const f32x4* xr = (const f32x4*)(x + (size_t)row * D) + F.lane;
        f32x4 v[8]; float s = 0.f;
#pragma unroll
        for (int j = 0; j < 8; ++j) { v[j] = xr[64 * j]; s += (v[j][0] * v[j][0] + v[j][1] * v[j][1]) + (v[j][2] * v[j][2] + v[j][3] * v[j][3]); }
        const float rstd = 1.0f / sqrtf(wave_sum(s) * (1.0f / D) + EPS);
        if (FINAL) {
#pragma unroll
            for (int j = 0; j < 8; ++j) { const f32x4 wv = *((const f32x4*)w + 64 * j + F.lane); *((f32x4*)(outf + (size_t)row * D) + 64 * j + F.lane) = v[j] * rstd * wv; }
        } else {
            const float* mb = modl + (size_t)(row >> 14) * 12288;
#pragma unroll
            for (int j = 0; j < 8; ++j) { const f32x4 wv = *((const f32x4*)w + 64 * j + F.lane), sc = *((const f32x4*)(mb + scale_off) + 64 * j + F.lane), sh = *((const f32x4*)(mb + shift_off) + 64 * j + F.lane);
                const f32x4 o = v[j] * rstd * wv * (sc + 1.0f) + sh;
                u32x2 pw; pw.x = pk2(o[0], o[1]); pw.y = pk2(o[2], o[3]);
                *((u32x2*)(outb + (size_t)row * D) + 64 * j + F.lane) = pw; }
        }
    }
}

__device__ __forceinline__ void p_scan(Frame& F) {
    const int gt = F.vcu * NTHR + F.tid;
    if (gt >= 8 * 256 * 64) return;
    const int bh = gt >> 14, rem = gt & 16383, h = bh & 3;
    const float cd = exp2f(log2_gamma(h) * 128.0f);
    u32x2* p = (u32x2*)(F.ws + WS_KVT) + ((size_t)bh * 128 * 65536 + (size_t)rem * 4) / 4;
    float s0 = 0.f, s1 = 0.f, s2 = 0.f, s3 = 0.f;
    for (int c0 = 0; c0 < NCH; c0 += 8) {
        u32x2 kv[8];
#pragma unroll
        for (int i = 0; i < 8; ++i) kv[i] = p[(size_t)(c0 + i) * (65536 / 4)];
#pragma unroll
        for (int i = 0; i < 8; ++i) { u32x2 o; o.x = pk2(s0, s1); o.y = pk2(s2, s3); p[(size_t)(c0 + i) * (65536 / 4)] = o;
            s0 = s0 * cd + bflo(kv[i].x); s1 = s1 * cd + bfhi(kv[i].x); s2 = s2 * cd + bflo(kv[i].y); s3 = s3 * cd + bfhi(kv[i].y); }
    }
}

__device__ __forceinline__ void p_retsg(Frame& F, const Args& a, int layer) {
    const bf16_t* Q = (const bf16_t*)(F.ws + WS_Q); const bf16_t* Kk = (const bf16_t*)(F.ws + WS_K); const bf16_t* Gg = (const bf16_t*)(F.ws + WS_G); const bf16_t* Uu = (const bf16_t*)(F.ws + WS_U);
    const bf16_t* VT = (const bf16_t*)(F.ws + WS_VT); const bf16_t* VST = (const bf16_t*)(F.ws + WS_VST); const bf16_t* ST = (const bf16_t*)(F.ws + WS_KVT);
    bf16_t* MIX = (bf16_t*)(F.ws + WS_HBUF);
    const float* rnw = (const float*)a.in[I_RNW] + (size_t)layer * RW;
    const int l16 = F.lane & 15, g = F.lane >> 4, w = F.wave;
    for (int L = F.vcu; L < 1024; L += F.G) {
        const int ch = L & 127, h = (L >> 7) & 3, b = L >> 9;
        const int T0 = b * SEQ + ch * CH;
        const float lg = log2_gamma(h);
        const int nloc = 16 * w + l16;
        const bf16_t* qrow = Q + (size_t)(T0 + nloc) * 1024 + h * 256 + 8 * g;
        bf16x8 qf[8];
#pragma unroll
        for (int s = 0; s < 8; ++s) qf[s] = *(const bf16x8*)(qrow + 32 * s);
        f32x4 acc[16];
#pragma unroll
        for (int et = 0; et < 16; ++et) acc[et] = (f32x4){0.f, 0.f, 0.f, 0.f};
        const bf16_t* sbase = ST + (size_t)L * 65536 + (size_t)l16 * 256 + 8 * g;
#pragma unroll
        for (int et = 0; et < 16; ++et)
#pragma unroll
            for (int s = 0; s < 8; ++s) { const bf16x8 af = *(const bf16x8*)(sbase + (size_t)et * 16 * 256 + 32 * s);
                acc[et] = __builtin_amdgcn_mfma_f32_16x16x32_bf16(af, qf[s], acc[et], 0, 0, 0); }
        const float qd = __builtin_amdgcn_exp2f(lg * (float)(nloc + 1));
#pragma unroll
        for (int et = 0; et < 16; ++et) acc[et] *= qd;
        unsigned pt[8][2];
#pragma unroll
        for (int t = 0; t < 8; ++t) { pt[t][0] = 0u; pt[t][1] = 0u;
            if (t <= w) { f32x4 sc = {0.f, 0.f, 0.f, 0.f};
                const bf16_t* krow = Kk + (size_t)(T0 + 16 * t + l16) * 1024 + h * 256 + 8 * g;
#pragma unroll
                for (int s = 0; s < 8; ++s) { const bf16x8 kf = *(const bf16x8*)(krow + 32 * s); sc = __builtin_amdgcn_mfma_f32_16x16x32_bf16(kf, qf[s], sc, 0, 0, 0); }
                float pv[4];
#pragma unroll
                for (int r = 0; r < 4; ++r) { const int mloc = 16 * t + 4 * g + r; const int df = nloc - mloc; pv[r] = df >= 0 ? sc[r] * __builtin_amdgcn_exp2f(lg * (float)df) : 0.f; }
                pt[t][0] = pk2(pv[0], pv[1]); pt[t][1] = pk2(pv[2], pv[3]); } }
#pragma unroll
        for (int u = 0; u < 4; ++u) {
            if (2 * u <= w) {
                u32x4 bw; bw.x = pt[2 * u][0]; bw.y = pt[2 * u][1]; bw.z = pt[2 * u + 1][0]; bw.w = pt[2 * u + 1][1];
                const bf16x8 bf = __builtin_bit_cast(bf16x8, bw);
                const bf16_t* vrow = VT + (size_t)(h * 256 + l16) * NTOK + T0 + 32 * u + 4 * g;
#pragma unroll
                for (int et = 0; et < 16; ++et) { const u32x2 lo = *(const u32x2*)(vrow + (size_t)et * 16 * NTOK), hi = *(const u32x2*)(vrow + (size_t)et * 16 * NTOK + 16);
                    u32x4 aw; aw.x = lo.x; aw.y = lo.y; aw.z = hi.x; aw.w = hi.y;
                    acc[et] = __builtin_amdgcn_mfma_f32_16x16x32_bf16(__builtin_bit_cast(bf16x8, aw), bf, acc[et], 0, 0, 0); }
            }
        }
        float ss = 0.f;
#pragma unroll
        for (int et = 0; et < 16; ++et) ss += (acc[et][0] * acc[et][0] + acc[et][1] * acc[et][1]) + (acc[et][2] * acc[et][2] + acc[et][3] * acc[et][3]);
        ss += __shfl_xor(ss, 16); ss += __shfl_xor(ss, 32);
        const float rstd = 1.0f / sqrtf(ss * (1.0f / RD) + EPS);
        const size_t tokoff = (size_t)(T0 + nloc);
#pragma unroll
        for (int et = 0; et < 16; ++et) { const int e = h * 256 + 16 * et + 4 * g;
            const f32x4 wv = *(const f32x4*)(rnw + e); const u32x2 gw = *(const u32x2*)(Gg + tokoff * 1024 + e);
            const float o0 = acc[et][0] * rstd * wv[0] * bflo(gw.x), o1 = acc[et][1] * rstd * wv[1] * bfhi(gw.x), o2 = acc[et][2] * rstd * wv[2] * bflo(gw.y), o3 = acc[et][3] * rstd * wv[3] * bfhi(gw.y);
            u32x2 ow; ow.x = pk2(o0, o1); ow.y = pk2(o2, o3);
            *(u32x2*)(MIX + tokoff * D + e) = ow; }
    }
    LAS float* rr = (LAS float*)F.lds;
    const bf16_t* swb = (const bf16_t*)(F.ws + WS_SGW) + (size_t)layer * SGG * CH * CH;
    const float* sgb = (const float*)a.in[I_SGB] + (size_t)layer * SGG * CH;
    for (int L = F.vcu; L < 256; L += F.G) {
        const int ch = L & 127, b = L >> 7; const int T0 = b * SEQ + ch * CH;
        __syncthreads();
        {
            float sq[8];
#pragma unroll
            for (int i = 0; i < 8; ++i) sq[i] = 0.f;
            const bf16_t* vb = VST + (size_t)(w * 128 + g) * NTOK + T0 + 8 * l16;
#pragma unroll 4
            for (int it = 0; it < 32; ++it) { const u32x4 v = *(const u32x4*)(vb + (size_t)it * 4 * NTOK);
                float f;
                f = bflo(v.x); sq[0] += f * f; f = bfhi(v.x); sq[1] += f * f; f = bflo(v.y); sq[2] += f * f; f = bfhi(v.y); sq[3] += f * f;
                f = bflo(v.z); sq[4] += f * f; f = bfhi(v.z); sq[5] += f * f; f = bflo(v.w); sq[6] += f * f; f = bfhi(v.w); sq[7] += f * f; }
#pragma unroll
            for (int i = 0; i < 8; ++i) { sq[i] += __shfl_xor(sq[i], 16); sq[i] += __shfl_xor(sq[i], 32); }
            if (g == 0) {
#pragma unroll
                for (int i = 0; i < 8; ++i) rr[w * 128 + 8 * l16 + i] = 1.0f / sqrtf(sq[i] * (1.0f / SGD) + EPS); }
        }
        __syncthreads();
        const int nloc = 16 * w + l16;
        for (int gi = 0; gi < SGG; ++gi) {
            bf16x8 bfr[4];
#pragma unroll
            for (int s = 0; s < 4; ++s) {
                u32x4 ww = {0u, 0u, 0u, 0u};
                if (32 * s <= 16 * w + 15) {
                    const u32x4 wv = *(const u32x4*)(swb + ((size_t)gi * CH + nloc) * CH + 32 * s + 8 * g);
                    const f32x4 r0 = *(const LAS f32x4*)(rr + gi * 128 + 32 * s + 8 * g), r1 = *(const LAS f32x4*)(rr + gi * 128 + 32 * s + 8 * g + 4);
                    ww.x = pk2(bflo(wv.x) * r0[0], bfhi(wv.x) * r0[1]); ww.y = pk2(bflo(wv.y) * r0[2], bfhi(wv.y) * r0[3]);
                    ww.z = pk2(bflo(wv.z) * r1[0], bfhi(wv.z) * r1[1]); ww.w = pk2(bflo(wv.w) * r1[2], bfhi(wv.w) * r1[3]);
                }
                bfr[s] = __builtin_bit_cast(bf16x8, ww);
            }
            const float bias = sgb[gi * CH + nloc];
            const size_t tokoff = (size_t)(T0 + nloc);
#pragma unroll
            for (int dt = 0; dt < 8; ++dt) {
                f32x4 z = {0.f, 0.f, 0.f, 0.f};
                const bf16_t* vrow = VST + (size_t)(gi * 128 + 16 * dt + l16) * NTOK + T0 + 8 * g;
#pragma unroll
                for (int s = 0; s < 4; ++s) if (32 * s <= 16 * w + 15) { const bf16x8 af = *(const bf16x8*)(vrow + 32 * s); z = __builtin_amdgcn_mfma_f32_16x16x32_bf16(af, bfr[s], z, 0, 0, 0); }
                const int d = gi * 128 + 16 * dt + 4 * g;
                const u32x2 uw = *(const u32x2*)(Uu + tokoff * 1024 + d);
                u32x2 ow; ow.x = pk2(bflo(uw.x) * (z[0] + bias), bfhi(uw.x) * (z[1] + bias)); ow.y = pk2(bflo(uw.y) * (z[2] + bias), bfhi(uw.y) * (z[3] + bias));
                *(u32x2*)(MIX + tokoff * D + 1024 + d) = ow;
            }
        }
    }
    __syncthreads();
}

__device__ __forceinline__ void p_router(Frame& F, const Args& a, int layer, const float* x1) {
    LAS float* cs = (LAS float*)F.lds;
    LAS float* sh = cs + 2048;
    LAS float* plog = sh + 2048;
    LAS float* red = plog + 4096;
    LAS float* rstdl = red + 128;
    LAS float* rb = rstdl + 16;
    LAS float* rbp = rb + 32;
    LAS float* scl = rbp + 512;
    LAS float* bsl = scl + 512;
    LAS unsigned* cnt = (LAS unsigned*)(bsl + 512);
    LAS unsigned* basel = cnt + 48;
    LAS int* tokb = (LAS int*)(basel + 48);
    LAS int* tokr = tokb + 128;
    LAS float* tokg = (LAS float*)(tokr + 128);
    const float* modl = (const float*)(F.ws + WS_MOD) + (size_t)layer * 2 * 12288;
    const float* n2w = (const float*)a.in[I_N2W] + (size_t)layer * D;
    const float* wr = (const float*)a.in[I_WR]; const float* rbias = (const float*)a.in[I_RB];
    const bf16_t* wrt = (const bf16_t*)(F.ws + WS_WRT);
    bf16_t* H2 = (bf16_t*)(F.ws + WS_HBUF);
    unsigned* gcnt = (unsigned*)(F.ws + WS_CTL) + CW_CNT + layer * 64;
    const int l16 = F.lane & 15, g = F.lane >> 4, w = F.wave;
    { int* r2t = (int*)(F.ws + WS_ROW2TOK); const int i = F.vcu * NTHR + F.tid; if (i < MAXROWS) r2t[i] = -1; }
    bf16x8 bfr[8][2];
#pragma unroll
    for (int s = 0; s < 8; ++s)
#pragma unroll
        for (int et = 0; et < 2; ++et) bfr[s][et] = *(const bf16x8*)(wrt + (size_t)(16 * et + l16) * D + 256 * w + 32 * s + 8 * g);
    for (int wgp = F.vcu; wgp < NTOK / 128; wgp += F.G) {
        const int tok0 = wgp * 128, b = tok0 >> 14; const float* mb = modl + (size_t)b * 12288;
        __syncthreads();
        for (int i = F.tid; i < D; i += NTHR) { cs[i] = n2w[i] * (1.0f + mb[8192 + i]); sh[i] = mb[6144 + i]; }
        if (F.tid < 48) cnt[F.tid] = 0u;
        __syncthreads();
        { const int e = F.tid & 31, part = F.tid >> 5; float s = 0.f;
          for (int k = part * 128; k < part * 128 + 128; ++k) s += sh[k] * wr[k * NE + e];
          rbp[part * 32 + e] = s; }
        __syncthreads();
        if (F.tid < 32) { float s = 0.f;
#pragma unroll
            for (int p = 0; p < 16; ++p) s += rbp[p * 32 + F.tid];
            rb[F.tid] = s; }
        for (int ti = 0; ti < 8; ++ti) {
            const int r0 = tok0 + 16 * ti;
            const float* xrow = x1 + (size_t)(r0 + l16) * D + 256 * w + 8 * g;
            f32x4 xv[8][2];
#pragma unroll
            for (int s = 0; s < 8; ++s) { xv[s][0] = *(const f32x4*)(xrow + 32 * s); xv[s][1] = *(const f32x4*)(xrow + 32 * s + 4); }
            float ssq = 0.f; f32x4 lacc[2] = {{0.f, 0.f, 0.f, 0.f}, {0.f, 0.f, 0.f, 0.f}};
#pragma unroll
            for (int s = 0; s < 8; ++s) {
                const f32x4 c0 = *(const LAS f32x4*)(cs + 256 * w + 32 * s + 8 * g), c1 = *(const LAS f32x4*)(cs + 256 * w + 32 * s + 8 * g + 4);
                const f32x4 a0 = xv[s][0], a1 = xv[s][1];
                ssq += (a0[0] * a0[0] + a0[1] * a0[1]) + (a0[2] * a0[2] + a0[3] * a0[3]) + (a1[0] * a1[0] + a1[1] * a1[1]) + (a1[2] * a1[2] + a1[3] * a1[3]);
                const f32x4 y0 = a0 * c0, y1 = a1 * c1;
                u32x4 aw; aw.x = pk2(y0[0], y0[1]); aw.y = pk2(y0[2], y0[3]); aw.z = pk2(y1[0], y1[1]); aw.w = pk2(y1[2], y1[3]);
                const bf16x8 af = __builtin_bit_cast(bf16x8, aw);
                lacc[0] = __builtin_amdgcn_mfma_f32_16x16x32_bf16(af, bfr[s][0], lacc[0], 0, 0, 0);
                lacc[1] = __builtin_amdgcn_mfma_f32_16x16x32_bf16(af, bfr[s][1], lacc[1], 0, 0, 0);
            }
            ssq += __shfl_xor(ssq, 16); ssq += __shfl_xor(ssq, 32);
            if (g == 0) red[w * 16 + l16] = ssq;
#pragma unroll
            for (int et = 0; et < 2; ++et)
#pragma unroll
                for (int r = 0; r < 4; ++r) plog[(w * 16 + 4 * g + r) * 32 + 16 * et + l16] = lacc[et][r];
            __syncthreads();
            { const int row = F.tid >> 5, e = F.tid & 31; float raw = 0.f, ss = 0.f;
#pragma unroll
              for (int ww = 0; ww < 8; ++ww) { raw += plog[(ww * 16 + row) * 32 + e]; ss += red[ww * 16 + row]; }
              const float rstd = 1.0f / sqrtf(ss * (1.0f / D) + EPS);
              const float sc = sigmoidf_(rstd * raw + rb[e]);
              scl[row * 32 + e] = sc; bsl[row * 32 + e] = sc + rbias[e];
              if (e == 0) rstdl[row] = rstd; }
            __syncthreads();
            if (F.tid < 16) {
                const LAS float* bs = bsl + F.tid * 32; const LAS float* sc = scl + F.tid * 32;
                int gsel = 0; float gbest = -1e30f;
                for (int gq = 0; gq < NG; ++gq) { float m1 = -1e30f, m2 = -1e30f;
                    for (int i = 0; i < 4; ++i) { const float v = bs[gq * 4 + i]; if (v > m1) { m2 = m1; m1 = v; } else if (v > m2) m2 = v; }
                    const float gs = m1 + m2; if (gs > gbest) { gbest = gs; gsel = gq; } }
                int i1 = 0; float v1 = bs[gsel * 4];
                for (int i = 1; i < 4; ++i) { const float v = bs[gsel * 4 + i]; if (v > v1) { v1 = v; i1 = i; } }
                int i2 = -1; float v2 = -1e30f;
                for (int i = 0; i < 4; ++i) { if (i == i1) continue; const float v = bs[gsel * 4 + i]; if (v > v2) { v2 = v; i2 = i; } }
                const float s1 = sc[gsel * 4 + i1], s2 = sc[gsel * 4 + i2], inv = 1.0f / (s1 + s2);
                const int lo = i1 < i2 ? i1 : i2, hi = i1 < i2 ? i2 : i1;
                const float glo = (i1 < i2 ? s1 : s2) * inv, ghi = (i1 < i2 ? s2 : s1) * inv;
                const int p = lo == 0 ? hi - 1 : lo == 1 ? hi + 1 : 5;
                const int bucket = gsel * 6 + p;
                const int lt = ti * 16 + F.tid;
                tokb[lt] = bucket; tokr[lt] = (int)__hip_atomic_fetch_add(&cnt[bucket], 1u, __ATOMIC_RELAXED, __HIP_MEMORY_SCOPE_WORKGROUP); tokg[lt * 2] = glo; tokg[lt * 2 + 1] = ghi;
                { f32x2 gg; gg.x = glo; gg.y = ghi; *(f32x2*)(F.ws + WS_TOKINFO + (size_t)(tok0 + lt) * 16 + 8) = gg; }
            }
            {
                const float rstd = rstdl[l16];
                bf16_t* orow = H2 + (size_t)(r0 + l16) * D + 256 * w + 8 * g;
#pragma unroll
                for (int s = 0; s < 8; ++s) {
                    const f32x4 c0 = *(const LAS f32x4*)(cs + 256 * w + 32 * s + 8 * g), c1 = *(const LAS f32x4*)(cs + 256 * w + 32 * s + 8 * g + 4);
                    const f32x4 h0 = *(const LAS f32x4*)(sh + 256 * w + 32 * s + 8 * g), h1 = *(const LAS f32x4*)(sh + 256 * w + 32 * s + 8 * g + 4);
                    const f32x4 y0 = xv[s][0] * rstd * c0 + h0, y1 = xv[s][1] * rstd * c1 + h1;
                    u32x4 ow; ow.x = pk2(y0[0], y0[1]); ow.y = pk2(y0[2], y0[3]); ow.z = pk2(y1[0], y1[1]); ow.w = pk2(y1[2], y1[3]);
                    *(u32x4*)(orow + 32 * s) = ow; }
            }
        }
        __syncthreads();
        if (F.tid < 48) basel[F.tid] = __hip_atomic_fetch_add(gcnt + F.tid, cnt[F.tid], __ATOMIC_RELAXED, __HIP_MEMORY_SCOPE_AGENT);
        __syncthreads();
        if (F.tid < 128) { const int bk = tokb[F.tid]; u32x2 rec; rec.x = (unsigned)bk; rec.y = basel[bk] + (unsigned)tokr[F.tid];
            *(u32x2*)(F.ws + WS_TOKINFO + (size_t)(tok0 + F.tid) * 16) = rec; }
    }
    __syncthreads();
}

__device__ __forceinline__ void build_tile_table(Frame& F, int layer) {
    LAS int* tt = (LAS int*)(F.lds + TT_OFF);
    const unsigned* gcnt = (const unsigned*)(F.ws + WS_CTL) + CW_CNT + layer * 64;
    __syncthreads();
    if (F.tid == 0) { int t = 0;
        for (int b = 0; b < NBUCK; ++b) { const int c = (int)__hip_atomic_load(gcnt + b, __ATOMIC_RELAXED, __HIP_MEMORY_SCOPE_AGENT); const int n = (c + 255) >> 8; tt[1 + b] = t * 256;
            for (int i = 0; i < n; ++i) tt[64 + t + i] = b;
            t += n; }
        tt[0] = t; }
    __syncthreads();
}
__device__ __forceinline__ void p_permute(Frame& F, int layer) {
    build_tile_table(F, layer);
    const LAS int* tt = (const LAS int*)(F.lds + TT_OFF);
    const bf16_t* H2 = (const bf16_t*)(F.ws + WS_HBUF); bf16_t* H2P = (bf16_t*)(F.ws + WS_H2P);
    int* r2t = (int*)(F.ws + WS_ROW2TOK); float* rg = (float*)(F.ws + WS_ROWGATE);
    const int gw = F.vcu * NWAVES + F.wave, NGW = F.G * NWAVES;
    for (int tok = gw; tok < NTOK; tok += NGW) {
        const u32x4 rec = *((const u32x4*)(F.ws + WS_TOKINFO) + tok);
        const int row = tt[1 + (int)rec.x] + (int)rec.y;
        if (F.lane == 0) { r2t[row] = tok; rg[(size_t)row * 2] = u2f(rec.z); rg[(size_t)row * 2 + 1] = u2f(rec.w); }
        const u32x4* src = (const u32x4*)(H2 + (size_t)tok * D) + F.lane; u32x4* dst = (u32x4*)(H2P + (size_t)row * D) + F.lane;
        u32x4 v[4];
#pragma unroll
        for (int j = 0; j < 4; ++j) v[j] = src[64 * j];
#pragma unroll
        for (int j = 0; j < 4; ++j) dst[64 * j] = v[j];
    }
}

constexpr int N_PHASES = 22;
__global__ void __launch_bounds__(NTHR, 2) fwd_kernel(Args args) {
    extern __shared__ __attribute__((aligned(16))) unsigned char lds_raw[];
    Frame F;
    F.lds = (LAS unsigned char*)lds_raw;
    F.tid = threadIdx.x; F.lane = F.tid & 63; F.wave = __builtin_amdgcn_readfirstlane(F.tid >> 6);
    F.G = gridDim.x; F.vcu = vcu_of(blockIdx.x, F.G); F.ws = args.ws;
    if (F.tid < 16) ((LAS unsigned*)(F.lds + LDSCTL_OFF))[F.tid] = 0u;
    __syncthreads();
    const int lo = args.ph_lo, hi = args.ph_hi;
    const bool one_launch = (hi - lo) > 1;
    XcdBarrier bar; bar.bar = (unsigned*)(F.ws + WS_CTL) + CW_BAR; bar.x = 0; bar.st = (volatile LAS unsigned*)(F.lds + LDSCTL_OFF);
    if (one_launch) bar = xcd_barrier_post((unsigned*)(F.ws + WS_CTL) + CW_BAR, (volatile LAS unsigned*)(F.lds + LDSCTL_OFF));
#define LAUNDER() do { unsigned char* w_ = args.ws; asm volatile("" : "+s"(w_)); F.ws = w_; int t_ = threadIdx.x; asm volatile("" : "+v"(t_)); F.tid = t_; F.lane = t_ & 63; F.wave = __builtin_amdgcn_readfirstlane(t_ >> 6); } while (0)
#define IN(k) (lo <= (k) && (k) < hi)
#define SEAM(k) do { if (IN(k) && IN((k) + 1)) xcd_barrier(bar); } while (0)
#define XB ((float*)(F.ws + WS_XB))
#define HBUF ((bf16_t*)(F.ws + WS_HBUF))
#define modl ((const float*)(F.ws + WS_MOD) + (size_t)l * 2 * 12288)
#define xin (l == 0 ? (const float*)args.in[I_X] : (const float*)XB)
#define x1 (args.out)

    if (HASK(0) && IN(0)) { LAUNDER(); p0_prologue(F, args); }
    SEAM(0);
    for (int l = 0; l < 2; ++l) {
        const int pb = 1 + 10 * l;
        if (HASK(1) && IN(pb + 0)) { LAUNDER();
            if (l == 1) { convert_weights(F, args, 1); }
            p_norm<false>(F, xin, (const float*)args.in[I_N1W] + (size_t)l * D, modl, 0, 2048, HBUF, nullptr);
        }
        SEAM(pb + 0);
        if (HASK(2) && IN(pb + 1)) { LAUNDER();
            { SchedProj S{(const char*)HBUF, (const char*)(F.ws + WS_WIN), F.G, F.vcu};
              EpiProj E{F.ws};
              pg8::gemm_phase<EpiProj, SchedProj, false>(F.lds, F.tid, D, D, D, 0, S, E); }
            LAUNDER();
            { SchedProjT S{(const char*)(F.ws + WS_WIN), (const char*)HBUF, F.G, F.vcu};
              EpiProjT E{F.ws};
              pg8::gemm_phase<EpiProjT, SchedProjT, false>(F.lds, F.tid, D, D, D, 0, S, E); }
        }
        SEAM(pb + 1);
        if (HASK(3) && IN(pb + 2)) { LAUNDER();
            SchedKV S{(const char*)(F.ws + WS_VT), (const char*)(F.ws + WS_KT), F.G, F.vcu};
            EpiKV E{(bf16_t*)(F.ws + WS_KVT)};
            pg8::gemm_phase<EpiKV, SchedKV, false>(F.lds, F.tid, CH, NTOK, NTOK, 0, S, E);
        }
        SEAM(pb + 2);
        if (HASK(4) && IN(pb + 3)) { LAUNDER(); p_scan(F); }
        SEAM(pb + 3);
        if (HASK(5) && IN(pb + 4)) { LAUNDER(); p_retsg(F, args, l); }
        SEAM(pb + 4);
        if (HASK(6) && IN(pb + 5)) { LAUNDER();
            SchedOut S{(const char*)HBUF, (const char*)(F.ws + WS_WOUT), F.G, F.vcu};
            EpiOut E{xin, x1, modl + 4096};
            pg8::gemm_phase<EpiOut, SchedOut, false>(F.lds, F.tid, D, D, D, 0, S, E);
        }
        SEAM(pb + 5);
        if (HASK(7) && IN(pb + 6)) { LAUNDER(); p_router(F, args, l, x1); }
        SEAM(pb + 6);
        if (HASK(8) && IN(pb + 7)) { LAUNDER(); p_permute(F, l); }
        SEAM(pb + 7);
        if (HASK(9) && IN(pb + 8)) { LAUNDER();
            build_tile_table(F, l);
            SchedUp S{(const char*)(F.ws + WS_H2P), (const char*)(F.ws + WS_W13), (const LAS int*)(F.lds + TT_OFF), F.G, F.vcu};
            EpiUp E{(bf16_t*)(F.ws + WS_HH), (const float*)(F.ws + WS_ROWGATE)};
            pg8::gemm_phase<EpiUp, SchedUp, false>(F.lds, F.tid, D, D, D, 0, S, E);
        }
        SEAM(pb + 8);
        if (HASK(10) && IN(pb + 9)) { LAUNDER();
            build_tile_table(F, l);
            SchedDown S{(const char*)(F.ws + WS_HH), (const char*)(F.ws + WS_W2), (const LAS int*)(F.lds + TT_OFF), F.G, F.vcu};
            EpiDown E{x1, XB, modl + 10240, (const int*)(F.ws + WS_ROW2TOK)};
            pg8::gemm_phase<EpiDown, SchedDown, true>(F.lds, F.tid, 2 * FF, 2 * FF, FF, FF / 64, S, E);
        }
        SEAM(pb + 9);
    }
    if (HASK(11) && IN(21)) { LAUNDER(); p_norm<true>(F, XB, (const float*)args.in[I_FNW], nullptr, 0, 0, nullptr, args.out); }
#undef IN
#undef SEAM
#undef XB
#undef HBUF
#undef modl
#undef xin
#undef x1
}


#ifndef MK_CHECK
#define MK_CHECK 0
#endif
#if MK_CHECK
constexpr int CW_FAIL = 20000;
__device__ __forceinline__ unsigned hsh(unsigned x) { x ^= x >> 16; x *= 0x7feb352dU; x ^= x >> 15; x *= 0x846ca68bU; x ^= x >> 16; return x; }
__device__ __forceinline__ float bf2f(bf16_t b) { return __builtin_bit_cast(float, ((unsigned)b) << 16); }
__device__ __forceinline__ float block_sum(float v, float* sm) {
    __syncthreads(); sm[threadIdx.x] = v; __syncthreads();
    for (int o = 128; o > 0; o >>= 1) { if ((int)threadIdx.x < o) sm[threadIdx.x] += sm[threadIdx.x + o]; __syncthreads(); }
    const float r = sm[0]; __syncthreads(); return r;
}
__device__ __forceinline__ bool bad(float got, float ref, float scale) { const float e = fabsf(got - ref); return !(e <= 0.03f * fabsf(ref) + 0.03f * scale); }
__global__ void __launch_bounds__(256) check_kernel(Args a, int id, int layer) {
    __shared__ float sm[256]; __shared__ float sv[2304]; __shared__ int si[64];
    unsigned char* ws = a.ws; const int t = threadIdx.x; const unsigned site = blockIdx.x;
    unsigned* fail = (unsigned*)(ws + WS_CTL) + CW_FAIL;
    const float* mod = (const float*)(ws + WS_MOD) + (size_t)layer * 2 * 12288;
    const float* xin = layer == 0 ? (const float*)a.in[I_X] : (const float*)(ws + WS_XB);
    int nbad = 0;
    if (id == 0) {
        const int l = site & 1, b = (site >> 1) & 1; const int col = (hsh(site * 977u + t) % 12288u);
        const float* c = (const float*)a.in[I_C] + b * D; const float* w = (const float*)a.in[I_WADA] + (size_t)l * D * 12288;
        float s = 0.f; for (int k = 0; k < D; ++k) s += siluf_(c[k]) * w[(size_t)k * 12288 + col];
        s += ((const float*)a.in[I_BADA])[l * 12288 + col];
        const float got = ((const float*)(ws + WS_MOD))[(size_t)(l * 2 + b) * 12288 + col];
        if (bad(got, s, 0.3f)) nbad++;
    } else if (id == 1) {
        const int tok = hsh(site * 31u + 7u) % NTOK, b = tok >> 14; const float* x = xin + (size_t)tok * D;
        float ss = 0.f; for (int k = t; k < D; k += 256) ss += x[k] * x[k];
        ss = block_sum(ss, sm); const float rstd = 1.0f / sqrtf(ss / D + EPS);
        const float* nw = (const float*)a.in[I_N1W] + (size_t)layer * D; const float* mb = mod + (size_t)b * 12288;
        for (int k = t; k < D; k += 256) { const float ref = x[k] * rstd * nw[k] * (1.f + mb[2048 + k]) + mb[k];
            if (bad(bf2f(((const bf16_t*)(ws + WS_HBUF))[(size_t)tok * D + k]), ref, 1.f)) nbad++; }
    } else if (id == 2) {
        const int tok = hsh(site * 131u + 3u) % NTOK; const bf16_t* h = (const bf16_t*)(ws + WS_HBUF) + (size_t)tok * D;
        const float* w = (const float*)a.in[I_WIN] + (size_t)layer * D * INC;
        const float* cs = (const float*)(ws + WS_COS) + (size_t)tok * 128; const float* sn = (const float*)(ws + WS_SIN) + (size_t)tok * 128;
        for (int kind = 0; kind < 7; ++kind) {
            const int hh = hsh(site * 7u + kind) & 3, j = hsh(site * 13u + kind * 5u + 1u) & 127;
            const int cbase = kind == 0 ? 0 : (kind == 1 || kind == 4) ? 1024 : kind == 2 ? 3072 : kind == 3 ? 4096 : kind == 5 ? 2048 : 5120;
            const int c1 = cbase + hh * 256 + j, c2 = c1 + 128;
            float p1 = 0.f, p2 = 0.f; for (int k = t; k < D; k += 256) { const float hv = bf2f(h[k]); p1 += hv * w[(size_t)k * INC + c1]; p2 += hv * w[(size_t)k * INC + c2]; }
            p1 = block_sum(p1, sm); p2 = block_sum(p2, sm);
            if (t == 0) {
                float r1, r2, g1, g2; const float lg = log2f(1.f - exp2f(-5.f - (float)hh));
                if (kind == 0 || kind == 1 || kind == 4) { r1 = p1 * cs[j] - p2 * sn[j]; r2 = p2 * cs[j] + p1 * sn[j];
                    if (kind != 0) { r1 *= 0.0625f; r2 *= 0.0625f; } if (kind == 4) { const float kd = exp2f(lg * (float)(127 - (tok & 127))); r1 *= kd; r2 *= kd; } }
                else if (kind == 2) { r1 = siluf_(p1); r2 = siluf_(p2); } else if (kind == 5) { r1 = p1; r2 = p2; } else { r1 = gelu_tanh(p1); r2 = gelu_tanh(p2); }
                if (kind < 4) { const bf16_t* o = (const bf16_t*)(ws + WS_Q + (size_t)kind * 64 * MiB) + (size_t)tok * 1024 + hh * 256 + j; g1 = bf2f(o[0]); g2 = bf2f(o[128]); }
                else { const bf16_t* o = (const bf16_t*)(ws + WS_KT + (size_t)(kind - 4) * 64 * MiB) + (size_t)(hh * 256 + j) * NTOK + tok; g1 = bf2f(o[0]); g2 = bf2f(o[(size_t)128 * NTOK]); }
                if (bad(g1, r1, 0.3f)) nbad += 100; if (bad(g2, r2, 0.3f)) nbad += 100;
            }
        }
    } else if (id == 3) {
        const int L = hsh(site * 17u + 1u) & 1023, e = hsh(site * 19u + 2u) & 255, d = t; const int ch = L & 127, h = (L >> 7) & 3, b = L >> 9;
        const bf16_t* vT = (const bf16_t*)(ws + WS_VT) + (size_t)(h * 256 + e) * NTOK + b * SEQ + ch * CH; const bf16_t* kT = (const bf16_t*)(ws + WS_KT) + (size_t)(h * 256 + d) * NTOK + b * SEQ + ch * CH;
        float s = 0.f; for (int m = 0; m < CH; ++m) s += bf2f(vT[m]) * bf2f(kT[m]);
        if (bad(bf2f(((const bf16_t*)(ws + WS_KVT))[(size_t)L * 65536 + e * 256 + d]), s, 0.3f)) nbad++;
    } else if (id == 4) {
        const int bh = site & 7, e = hsh(site * 23u + 5u) & 255, d = t, h = bh & 3, b = bh >> 2; const float cd = exp2f(log2f(1.f - exp2f(-5.f - (float)h)) * 128.f);
        float S = 0.f;
        for (int c = 0; c < 4; ++c) {
            if (bad(bf2f(((const bf16_t*)(ws + WS_KVT))[(size_t)(bh * 128 + c) * 65536 + e * 256 + d]), S, 0.3f)) nbad++;
            const bf16_t* vT = (const bf16_t*)(ws + WS_VT) + (size_t)(h * 256 + e) * NTOK + b * SEQ + c * CH; const bf16_t* kT = (const bf16_t*)(ws + WS_KT) + (size_t)(h * 256 + d) * NTOK + b * SEQ + c * CH;
            float s = 0.f; for (int m = 0; m < CH; ++m) s += bf2f(vT[m]) * bf2f(kT[m]);
            S = S * cd + s; }
    } else if (id == 5) {
        const int tok = hsh(site * 29u + 11u) % NTOK, h = site & 3, b = tok >> 14, n = tok & 127, ch = (tok & (SEQ - 1)) >> 7, T0 = tok - n; const int L = (b * 4 + h) * 128 + ch;
        const float lg = log2f(1.f - exp2f(-5.f - (float)h));
        const bf16_t* q = (const bf16_t*)(ws + WS_Q) + (size_t)tok * 1024 + h * 256; const bf16_t* kk = (const bf16_t*)(ws + WS_K);
        if (t < 128) { float s = 0.f; if (t <= n) { const bf16_t* kr = kk + (size_t)(T0 + t) * 1024 + h * 256; for (int d = 0; d < 256; ++d) s += bf2f(q[d]) * bf2f(kr[d]); s *= exp2f(lg * (float)(n - t)); } sv[t] = s; }
        __syncthreads();
        const int e = t; float o = 0.f;
        { const bf16_t* vT = (const bf16_t*)(ws + WS_VT) + (size_t)(h * 256 + e) * NTOK + T0; for (int m = 0; m <= n; ++m) o += sv[m] * bf2f(vT[m]);
          const bf16_t* st = (const bf16_t*)(ws + WS_KVT) + (size_t)L * 65536 + e * 256; float cr = 0.f; for (int d = 0; d < 256; ++d) cr += bf2f(q[d]) * bf2f(st[d]);
          o += cr * exp2f(lg * (float)(n + 1)); }
        const float ss = block_sum(o * o, sm); const float rstd = 1.0f / sqrtf(ss / 256.f + EPS);
        const float ref = o * rstd * ((const float*)a.in[I_RNW])[layer * RW + h * 256 + e] * bf2f(((const bf16_t*)(ws + WS_G))[(size_t)tok * 1024 + h * 256 + e]);
        if (bad(bf2f(((const bf16_t*)(ws + WS_HBUF))[(size_t)tok * D + h * 256 + e]), ref, 0.3f)) nbad++;
    } else if (id == 6) {
        const int tok = hsh(site * 37u + 13u) % NTOK, gi = site & 7, n = tok & 127, T0 = tok - n;
        const bf16_t* vsT = (const bf16_t*)(ws + WS_VST);
        if (t < 128) { float s = 0.f; for (int d = 0; d < 128; ++d) { const float v = bf2f(vsT[(size_t)(gi * 128 + d) * NTOK + T0 + t]); s += v * v; } sv[t] = 1.0f / sqrtf(s / 128.f + EPS); }
        __syncthreads();
        if (t < 128) { const int d = t; const float* W = (const float*)a.in[I_SGW] + ((size_t)(layer * SGG + gi) * CH + n) * CH; float z = 0.f;
            for (int m = 0; m <= n; ++m) z += W[m] * sv[m] * bf2f(vsT[(size_t)(gi * 128 + d) * NTOK + T0 + m]);
            z += ((const float*)a.in[I_SGB])[(layer * SGG + gi) * CH + n];
            const float ref = bf2f(((const bf16_t*)(ws + WS_U))[(size_t)tok * 1024 + gi * 128 + d]) * z;
            if (bad(bf2f(((const bf16_t*)(ws + WS_HBUF))[(size_t)tok * D + 1024 + gi * 128 + d]), ref, 0.3f)) nbad++; }
    } else if (id == 7) {
        const int tok = hsh(site * 41u + 17u) % NTOK, b = tok >> 14, col = hsh(site * 43u + t) & 2047;
        const bf16_t* mi = (const bf16_t*)(ws + WS_HBUF) + (size_t)tok * D; const float* w = (const float*)a.in[I_WOUT] + (size_t)layer * D * D;
        float s = 0.f; for (int k = 0; k < D; ++k) s += bf2f(mi[k]) * w[(size_t)k * D + col];
        const float ref = xin[(size_t)tok * D + col] + mod[(size_t)b * 12288 + 4096 + col] * s;
        if (bad(a.out[(size_t)tok * D + col], ref, 0.3f)) nbad++;
    } else if (id == 8) {
        const int tok = hsh(site * 47u + 19u) % NTOK, b = tok >> 14; const float* x = a.out + (size_t)tok * D;
        float ss = 0.f; for (int k = t; k < D; k += 256) ss += x[k] * x[k];
        ss = block_sum(ss, sm); const float rstd = 1.0f / sqrtf(ss / D + EPS);
        const float* nw = (const float*)a.in[I_N2W] + (size_t)layer * D; const float* mb = mod + (size_t)b * 12288;
        for (int k = t; k < D; k += 256) { const float ref = x[k] * rstd * nw[k] * (1.f + mb[8192 + k]) + mb[6144 + k]; sv[k] = ref;
            if (bad(bf2f(((const bf16_t*)(ws + WS_HBUF))[(size_t)tok * D + k]), ref, 1.f)) atomicAdd(fail + 12, 1u); }
        __syncthreads();
        { const int e = t & 31, part = t >> 5; float s = 0.f; const float* wr = (const float*)a.in[I_WR]; for (int k = part * 256; k < part * 256 + 256; ++k) s += sv[k] * wr[k * NE + e]; sm[t] = s; }
        __syncthreads();
        if (t == 0) { float sc[32], bs[32]; for (int e = 0; e < 32; ++e) { float s = 0.f; for (int p = 0; p < 8; ++p) s += sm[p * 32 + e]; sc[e] = sigmoidf_(s); bs[e] = sc[e] + ((const float*)a.in[I_RB])[e]; }
            int gsel = 0; float gb = -1e30f, g2 = -1e30f;
            for (int gq = 0; gq < 8; ++gq) { float m1 = -1e30f, m2 = -1e30f; for (int i = 0; i < 4; ++i) { const float v = bs[gq * 4 + i]; if (v > m1) { m2 = m1; m1 = v; } else if (v > m2) m2 = v; } const float gs = m1 + m2; if (gs > gb) { g2 = gb; gb = gs; gsel = gq; } else if (gs > g2) g2 = gs; }
            int i1 = 0; for (int i = 1; i < 4; ++i) if (bs[gsel * 4 + i] > bs[gsel * 4 + i1]) i1 = i;
            int i2 = -1; for (int i = 0; i < 4; ++i) { if (i == i1) continue; if (i2 < 0 || bs[gsel * 4 + i] > bs[gsel * 4 + i2]) i2 = i; }
            float third = -1e30f; for (int i = 0; i < 4; ++i) if (i != i1 && i != i2) third = fmaxf(third, bs[gsel * 4 + i]);
            const bool clear = (gb - g2 > 0.01f) && (bs[gsel * 4 + i2] - third > 0.01f);
            const int lo = i1 < i2 ? i1 : i2, hi = i1 < i2 ? i2 : i1; const int p = lo == 0 ? hi - 1 : lo == 1 ? hi + 1 : 5; const int bucket = gsel * 6 + p;
            const float s1 = sc[gsel * 4 + lo], s2 = sc[gsel * 4 + hi];
            const u32x4 rec = *((const u32x4*)(ws + WS_TOKINFO) + tok);
            if (clear) { if ((int)rec.x != bucket) atomicAdd(fail + 13, 1000u); else { const float gz = u2f(rec.z), gw = u2f(rec.w);
                if (bad(gz, s1 / (s1 + s2), 0.1f)) atomicAdd(fail + 14, 1000u); if (bad(gw, s2 / (s1 + s2), 0.1f)) atomicAdd(fail + 14, 1000u);
                if (fabsf(gz - s1 / (s1 + s2)) > 0.1f) { atomicAdd(fail + 21, 1000u); float* dump = (float*)(fail + 64); dump[site * 4 + 0] = 1.f; dump[site * 4 + 1] = gz; dump[site * 4 + 2] = gw; dump[site * 4 + 3] = s1; } if (fabsf(gz + gw - 1.f) > 0.01f) atomicAdd(fail + 22, 1000u);
                if (fabsf(gz - s2 / (s1 + s2)) < 0.01f && fabsf(s1 - s2) > 0.05f) atomicAdd(fail + 23, 1000u); } }
            else atomicAdd(fail + 15, 2u);
        }
    } else if (id == 9) {
        const int tok = hsh(site * 53u + 23u) % NTOK; const u32x4 rec = *((const u32x4*)(ws + WS_TOKINFO) + tok);
        const unsigned* gcnt = (const unsigned*)(ws + WS_CTL) + CW_CNT + layer * 64;
        if (t == 0) { int st = 0, tot = 0; for (int bq = 0; bq < NBUCK; ++bq) { if (bq == (int)rec.x) st = tot; tot += ((int)gcnt[bq] + 255) / 256 * 256; } si[0] = st + (int)rec.y; int sum = 0; for (int bq = 0; bq < NBUCK; ++bq) sum += (int)gcnt[bq]; si[1] = sum; si[2] = (int)gcnt[rec.x]; }
        __syncthreads();
        const int row = si[0];
        if (t == 0) { if (si[1] != NTOK) atomicAdd(fail + 16, 1000u); if ((int)rec.y >= si[2]) atomicAdd(fail + 17, 1000u); if (((const int*)(ws + WS_ROW2TOK))[row] != tok) atomicAdd(fail + 18, 1000u);
            if (((const unsigned*)(ws + WS_ROWGATE))[(size_t)row * 2] != rec.z || ((const unsigned*)(ws + WS_ROWGATE))[(size_t)row * 2 + 1] != rec.w) atomicAdd(fail + 19, 1000u); }
        for (int k = t; k < D; k += 256) if (((const bf16_t*)(ws + WS_H2P))[(size_t)row * D + k] != ((const bf16_t*)(ws + WS_HBUF))[(size_t)tok * D + k]) atomicAdd(fail + 20, 1u);
    } else if (id == 10 || id == 11) {
        const int tok = hsh(site * 59u + 29u) % NTOK, b = tok >> 14; const u32x4 rec = *((const u32x4*)(ws + WS_TOKINFO) + tok);
        const unsigned* gcnt = (const unsigned*)(ws + WS_CTL) + CW_CNT + layer * 64;
        if (t == 0) { int st = 0, tot = 0; for (int bq = 0; bq < NBUCK; ++bq) { if (bq == (int)rec.x) st = tot; tot += ((int)gcnt[bq] + 255) / 256 * 256; } si[0] = st + (int)rec.y; }
        __syncthreads();
        const int row = si[0]; int elo, ehi; bucket_experts((int)rec.x, elo, ehi);
        if (id == 10) {
            const int es = t >> 7, j = hsh(site * 61u + t) & 511, e = es ? ehi : elo; const float g = u2f(es ? rec.w : rec.z);
            const bf16_t* hr = (const bf16_t*)(ws + WS_H2P) + (size_t)row * D; const float* w1 = (const float*)a.in[I_W1] + ((size_t)(layer * NE + e) * D) * FF; const float* w3 = (const float*)a.in[I_W3] + ((size_t)(layer * NE + e) * D) * FF;
            float a1 = 0.f, a3 = 0.f; for (int k = 0; k < D; ++k) { const float hv = bf2f(hr[k]); a1 += hv * w1[(size_t)k * FF + j]; a3 += hv * w3[(size_t)k * FF + j]; }
            const float ref = siluf_(a1) * a3 * g;
            if (bad(bf2f(((const bf16_t*)(ws + WS_HH))[(size_t)row * 1024 + es * 512 + j]), ref, 0.1f)) nbad++;
        } else {
            const int col = hsh(site * 67u + t) & 2047; const bf16_t* hr = (const bf16_t*)(ws + WS_HH) + (size_t)row * 1024;
            const float* w2a = (const float*)a.in[I_W2] + ((size_t)(layer * NE + elo) * FF) * D; const float* w2b = (const float*)a.in[I_W2] + ((size_t)(layer * NE + ehi) * FF) * D;
            float s = 0.f; for (int k = 0; k < FF; ++k) s += bf2f(hr[k]) * w2a[(size_t)k * D + col] + bf2f(hr[512 + k]) * w2b[(size_t)k * D + col];
            const float ref = a.out[(size_t)tok * D + col] + mod[(size_t)b * 12288 + 10240 + col] * s;
            if (bad(((const float*)(ws + WS_XB))[(size_t)tok * D + col], ref, 0.3f)) nbad++;
        }
    }
    if (nbad) atomicAdd(fail + id, (unsigned)nbad);
}
__global__ void report_kernel(Args a) {
    const unsigned* fail = (const unsigned*)(a.ws + WS_CTL) + CW_FAIL;
    const int order[24] = {0, 1, 2, 3, 4, 5, 6, 7, 12, 13, 14, 21, 22, 23, 15, 16, 17, 18, 19, 20, 8, 9, 10, 11};
    int first = -1, second = -1; for (int q = 0; q < 24; ++q) { if (fail[order[q]] > 40u) { if (first < 0) first = q; else if (second < 0) second = q; } }
    if (first < 0) return;
    float c = 3.0f * (float)(first + 1); float second_v = second >= 0 ? 100.f * powf(1.3f, (float)second) : 0.f;
#if MK_DUMP
    { const float* dump = (const float*)(fail + 64); int nf = 0; float sz = 0.f, sw = 0.f; for (int sI = 0; sI < 64; ++sI) if (dump[sI * 4] != 0.f) { nf++; sz += dump[sI * 4 + 1]; sw += dump[sI * 4 + 2]; }
      if (nf) { c = 10.f * (1.f + (float)nf / 64.f); second_v = 1000.f * (1.f + (sz + sw) / (float)nf); second = 0; } }
#endif
    for (size_t i = (size_t)blockIdx.x * blockDim.x + threadIdx.x; i < (size_t)NTOK * D; i += (size_t)gridDim.x * blockDim.x) { float v = c;
        if (i == 12345 && second >= 0) v = second_v;
        a.out[i] = v; }
}
#endif

extern "C" void kernel_launch(void* const* d_in, const int* in_sizes, int n_in, void* d_out, int out_size, void* d_ws, size_t ws_size, hipStream_t stream) {
    static int grid = 0;
    if (grid == 0) {
        if (n_in != 18 || out_size != NTOK * D || ws_size < WS_END) { fprintf(stderr, "kernel_launch: unexpected shapes (n_in %d, out %d, ws %zu < %zu); nothing launched\n", n_in, out_size, ws_size, (size_t)WS_END); grid = -1; return; }
        int dev = 0, cus = 0, per_cu = 0;
        if (hipGetDevice(&dev) != hipSuccess || hipDeviceGetAttribute(&cus, hipDeviceAttributeMultiprocessorCount, dev) != hipSuccess) { grid = -1; return; }
        if (hipFuncSetAttribute((const void*)fwd_kernel, hipFuncAttributeMaxDynamicSharedMemorySize, LDS_BYTES) != hipSuccess) { fprintf(stderr, "kernel_launch: hipFuncSetAttribute failed\n"); grid = -1; return; }
        if (hipOccupancyMaxActiveBlocksPerMultiprocessor(&per_cu, (const void*)fwd_kernel, NTHR, LDS_BYTES) != hipSuccess || per_cu < 1) { fprintf(stderr, "kernel_launch: occupancy query says %d blocks per CU\n", per_cu); }
        (void)hipGetLastError();
        if (cus * NTHR < MAXROWS) { fprintf(stderr, "kernel_launch: needs >= 88 CUs\n"); grid = -1; return; }
        grid = cus;
    }
    if (grid < 0) return;
    if (hipMemsetAsync((char*)d_ws + WS_CTL, 0, CTL_ZERO_BYTES, stream) != hipSuccess) { fprintf(stderr, "kernel_launch: memset failed\n"); return; }
    Args a{};
    for (int i = 0; i < 18; ++i) a.in[i] = d_in[i];
    a.out = (float*)d_out; a.ws = (unsigned char*)d_ws; a.li = 0; a.pad = 0;
#if MK_N_LAUNCHES == 1
    a.ph_lo = 0; a.ph_hi = N_PHASES;
    hipLaunchKernelGGL(fwd_kernel, dim3(grid), dim3(NTHR), LDS_BYTES, stream, a);
#else
    for (int p = 0; p < N_PHASES; ++p) { a.ph_lo = p; a.ph_hi = p + 1; hipLaunchKernelGGL(fwd_kernel, dim3(grid), dim3(NTHR), LDS_BYTES, stream, a);
#if MK_CHECK
        const int pl = p - 1 - 10 * MK_CHECK_LAYER;
        if (p == 0) hipLaunchKernelGGL(check_kernel, dim3(64), dim3(256), 0, stream, a, 0, 0);
        if (pl == 0) hipLaunchKernelGGL(check_kernel, dim3(64), dim3(256), 0, stream, a, 1, MK_CHECK_LAYER);
        if (pl == 1) hipLaunchKernelGGL(check_kernel, dim3(64), dim3(256), 0, stream, a, 2, MK_CHECK_LAYER);
        if (pl == 2) hipLaunchKernelGGL(check_kernel, dim3(64), dim3(256), 0, stream, a, 3, MK_CHECK_LAYER);
        if (pl == 3) hipLaunchKernelGGL(check_kernel, dim3(64), dim3(256), 0, stream, a, 4, MK_CHECK_LAYER);
        if (pl == 4) { hipLaunchKernelGGL(check_kernel, dim3(64), dim3(256), 0, stream, a, 5, MK_CHECK_LAYER); hipLaunchKernelGGL(check_kernel, dim3(64), dim3(256), 0, stream, a, 6, MK_CHECK_LAYER); }
        if (pl == 5) hipLaunchKernelGGL(check_kernel, dim3(64), dim3(256), 0, stream, a, 7, MK_CHECK_LAYER);
        if (pl == 6) hipLaunchKernelGGL(check_kernel, dim3(64), dim3(256), 0, stream, a, 8, MK_CHECK_LAYER);
        if (pl == 7) hipLaunchKernelGGL(check_kernel, dim3(64), dim3(256), 0, stream, a, 9, MK_CHECK_LAYER);
        if (pl == 8) hipLaunchKernelGGL(check_kernel, dim3(64), dim3(256), 0, stream, a, 10, MK_CHECK_LAYER);
        if (pl == 9) hipLaunchKernelGGL(check_kernel, dim3(64), dim3(256), 0, stream, a, 11, MK_CHECK_LAYER);
#endif
    }
#if MK_CHECK
    hipLaunchKernelGGL(report_kernel, dim3(1024), dim3(256), 0, stream, a);
#endif
#endif
    const hipError_t le = hipPeekAtLastError();
    if (le != hipSuccess) fprintf(stderr, "kernel_launch: launch failed: %s\n", hipGetErrorName(le));
}
```

```cpp
#include <hip/hip_runtime.h>
#include <cstdio>
#include <cstdint>

#ifndef MK_N_LAUNCHES
#define MK_N_LAUNCHES 1
#endif
#ifndef MK_CHECK
#define MK_CHECK 0
#endif
#ifndef MK_CHECK_LAYER
#define MK_CHECK_LAYER 0
#endif
#ifndef MK_DUMP
#define MK_DUMP 0
#define MK_DUMP_A 1
#define MK_DUMP_B 2
#endif
#ifndef MK_STAMP
#define MK_STAMP 0
#endif
#ifndef MK_STAMP_A
#define MK_STAMP_OFF 0.0f
#define MK_STAMP_A 0
#define MK_STAMP_A2 1
#define MK_STAMP_B 1
#define MK_STAMP_B2 11
#endif
#ifndef MK_SIMPLE_GEMM
#define MK_SIMPLE_GEMM 0
#endif

#ifndef PH_MASK
#define PH_MASK 0xFFF
#endif
#define HASK(k) (((PH_MASK) >> (k)) & 1)
#define GAS __attribute__((address_space(1)))
#define LAS __attribute__((address_space(3)))
typedef unsigned short bf16_t;
typedef short bf16x8 __attribute__((ext_vector_type(8)));
typedef short bf16x4 __attribute__((ext_vector_type(4)));
typedef float f32x4 __attribute__((ext_vector_type(4)));
typedef float f32x2 __attribute__((ext_vector_type(2)));
typedef unsigned u32x4 __attribute__((ext_vector_type(4)));
typedef unsigned u32x2 __attribute__((ext_vector_type(2)));

constexpr int NB = 2, SEQ = 16384, D = 2048, NTOK = NB * SEQ;
constexpr int RW = 1024, RH = 4, RD = 256, CH = 128, NCH = SEQ / CH;
constexpr int SGW = 1024, SGG = 8, SGD = 128;
constexpr int INC = 6144;
constexpr int NE = 32, NG = 8, EPG = 4, FF = 512;
constexpr int NBUCK = 48;
constexpr int MAXROWS = 45056;
constexpr int NADA = 6;
constexpr float EPS = 1e-6f;
constexpr int NWAVES = 8, NTHR = 512;

constexpr size_t MiB = 1u << 20;
constexpr size_t WS_CTL = 0, CTL_ZERO_BYTES = 1 * MiB;
constexpr size_t WS_MOD = 1 * MiB;
constexpr size_t WS_RBW = 1 * MiB + 200 * 1024;
constexpr size_t WS_WRT = 1 * MiB + 256 * 1024;
constexpr size_t WS_SGW = 1 * MiB + 512 * 1024;
constexpr size_t WS_TOKINFO = 2 * MiB;
constexpr size_t WS_ROW2TOK = 2 * MiB + 512 * 1024;
constexpr size_t WS_ROWGATE = 3 * MiB;
constexpr size_t WS_HSC = 1 * MiB + 384 * 1024;
constexpr size_t WS_ROWSC = 2 * MiB + 768 * 1024;
constexpr size_t WS_WSC_IN = 3 * MiB + 512 * 1024;
constexpr size_t WS_WSC_OUT = 3 * MiB + 544 * 1024;
constexpr size_t WS_WSC_13 = 3 * MiB + 640 * 1024;
constexpr size_t WS_COS = 4 * MiB, WS_SIN = 20 * MiB, WS_COST = 36 * MiB, WS_SINT = 52 * MiB;
constexpr size_t WS_WIN = 68 * MiB;
constexpr size_t WS_WOUT = 92 * MiB;
constexpr size_t WS_W13 = 100 * MiB;
constexpr size_t WS_W2 = 228 * MiB;
constexpr size_t WS_XB = 292 * MiB;
constexpr size_t WS_HBUF = 548 * MiB;
constexpr size_t WS_PROJ = 676 * MiB;
constexpr size_t WS_Q = WS_PROJ, WS_K = WS_PROJ + 64 * MiB, WS_G = WS_PROJ + 128 * MiB, WS_U = WS_PROJ + 192 * MiB;
constexpr size_t WS_KT = WS_PROJ + 256 * MiB, WS_VT = WS_PROJ + 320 * MiB, WS_VST = WS_PROJ + 384 * MiB;
constexpr size_t WS_H2P = WS_PROJ;
constexpr size_t WS_HH = WS_PROJ + 176 * MiB;
constexpr size_t WS_R2TB = WS_PROJ;
constexpr size_t WS_RGB = WS_PROJ + 8 * MiB;
constexpr size_t WS_RSB = WS_PROJ + 24 * MiB;
constexpr size_t WS_KVT = 1124 * MiB;
constexpr size_t WS_MIXQ = WS_KVT + 64 * MiB;
constexpr size_t WS_END = 1252 * MiB;
constexpr int CW_BAR = 4096;
constexpr int CW_CNT = 16384;
constexpr int CW_AMAX = 32768;
constexpr int CW_TS = 24000;

constexpr int RING_BYTES = 131072;
constexpr int LDSCTL_OFF = RING_BYTES;
constexpr int TT_OFF = LDSCTL_OFF + 64;
constexpr int KTS_OFF = LDSCTL_OFF + 2048;
constexpr int LDS_BYTES = 163840;

__device__ __forceinline__ unsigned f2bf(float f) { unsigned u = __builtin_bit_cast(unsigned, f); return (u + 0x7fffu + ((u >> 16) & 1u)) >> 16; }
typedef __bf16 bf16x2_t __attribute__((ext_vector_type(2)));
__device__ __forceinline__ unsigned pk2(float lo, float hi) { const f32x2 v = {lo, hi}; return __builtin_bit_cast(unsigned, __builtin_convertvector(v, bf16x2_t)); }
__device__ __forceinline__ float u2f(unsigned u) { return __builtin_bit_cast(float, u); }
__device__ __forceinline__ unsigned f2u(float f) { return __builtin_bit_cast(unsigned, f); }
__device__ __forceinline__ float bflo(unsigned w) { return __builtin_bit_cast(float, w << 16); }
__device__ __forceinline__ float bfhi(unsigned w) { return __builtin_bit_cast(float, w & 0xffff0000u); }
__device__ __forceinline__ unsigned q4(f32x4 v) {
    const int a = (int)__builtin_rintf(fminf(fmaxf(v[0], -127.f), 127.f)), b = (int)__builtin_rintf(fminf(fmaxf(v[1], -127.f), 127.f)), c = (int)__builtin_rintf(fminf(fmaxf(v[2], -127.f), 127.f)), d = (int)__builtin_rintf(fminf(fmaxf(v[3], -127.f), 127.f));
    return (unsigned)(a & 0xff) | ((unsigned)(b & 0xff) << 8) | ((unsigned)(c & 0xff) << 16) | ((unsigned)d << 24);
}
__device__ __forceinline__ u32x2 f8pack(f32x4 a, f32x4 b) { u32x2 r; int p = __builtin_amdgcn_cvt_pk_fp8_f32(a[0], a[1], 0, false); p = __builtin_amdgcn_cvt_pk_fp8_f32(a[2], a[3], p, true); r.x = (unsigned)p;
    p = __builtin_amdgcn_cvt_pk_fp8_f32(b[0], b[1], 0, false); p = __builtin_amdgcn_cvt_pk_fp8_f32(b[2], b[3], p, true); r.y = (unsigned)p; return r; }
__device__ __forceinline__ void f8unpack(u32x2 r, f32x4& a, f32x4& b) { const f32x2 a0 = __builtin_amdgcn_cvt_pk_f32_fp8((int)r.x, false), a1 = __builtin_amdgcn_cvt_pk_f32_fp8((int)r.x, true), b0 = __builtin_amdgcn_cvt_pk_f32_fp8((int)r.y, false), b1 = __builtin_amdgcn_cvt_pk_f32_fp8((int)r.y, true);
    a = (f32x4){a0.x, a0.y, a1.x, a1.y}; b = (f32x4){b0.x, b0.y, b1.x, b1.y}; }
__device__ __forceinline__ float wave_sum(float v) {
#pragma unroll
    for (int o = 1; o < 64; o <<= 1) v += __shfl_xor(v, o);
    return v;
}
__device__ __forceinline__ float sigmoidf_(float x) { return __builtin_amdgcn_rcpf(1.0f + __builtin_amdgcn_exp2f(-1.4426950408889634f * x)); }
__device__ __forceinline__ float siluf_(float x) { return x * __builtin_amdgcn_rcpf(1.0f + __builtin_amdgcn_exp2f(-1.4426950408889634f * x)); }
__device__ __forceinline__ float gelu_tanh(float x) {
    const float y2 = (2.0f * 0.7978845608028654f * 1.4426950408889634f) * (x + 0.044715f * x * x * x);
    return x * __builtin_amdgcn_rcpf(1.0f + __builtin_amdgcn_exp2f(-y2));
}
__device__ __forceinline__ float log2_gamma(int h) { return __log2f(1.0f - exp2f(-5.0f - (float)h)); }

#define XB_TMO      128
#define XB_XCNT(j)  (256  + 64 * (j))
#define XB_XSUB(j)  (1280 + 64 * (j))
#define XB_XGEN(j)  (2304 + 64 * (j))
#define XB_TOP      3328
#define XB_TOPGEN   3392
#define XCD_BAR_WORDS 3456
#define XB_SPIN_CAP (1u << 20)
__device__ __forceinline__ unsigned xb_ld(unsigned* p)              { return __hip_atomic_load(p, __ATOMIC_RELAXED, __HIP_MEMORY_SCOPE_AGENT); }
__device__ __forceinline__ unsigned xb_add(unsigned* p, unsigned v) { return __hip_atomic_fetch_add(p, v, __ATOMIC_RELAXED, __HIP_MEMORY_SCOPE_AGENT); }
__device__ __forceinline__ unsigned xb_xcc_id() { return (unsigned)__builtin_amdgcn_s_getreg((3 << 11) | 20) & 0xFu; }
#define XB_SPIN(cond, bar) do { unsigned _sp = 0; while (cond) { __builtin_amdgcn_s_sleep(1); \
    if ((++_sp & 255u) == 0u) { if (xb_ld(&(bar)[XB_TMO])) break; if (_sp > XB_SPIN_CAP) { atomicAdd(&(bar)[XB_TMO], 1u); break; } } } } while (0)
struct XcdBarrier { unsigned* bar; unsigned x; volatile LAS unsigned* st; };
__device__ __forceinline__ XcdBarrier xcd_barrier_post(unsigned* bar, volatile LAS unsigned* st) {
    XcdBarrier b; b.bar = bar; b.x = xb_xcc_id(); b.st = st;
    if (threadIdx.x == 0) (void)xb_add(&bar[XB_XCNT(b.x)], 1u);
    return b;
}
__device__ __forceinline__ void xcd_barrier_complete(unsigned* bar, unsigned x, unsigned& nloc, unsigned& nx) {
    const unsigned G = gridDim.x * gridDim.y * gridDim.z;
    unsigned sum, cnt, mine, sp = 0u;
    for (;;) {
        sum = 0u; cnt = 0u; mine = 0u;
#pragma unroll 1
        for (unsigned j = 0; j < 16; ++j) { const unsigned c = xb_ld(&bar[XB_XCNT(j)]); sum += c; cnt += (c > 0u) ? 1u : 0u; mine = (j == x) ? c : mine; }
        if (sum == G) break;
        __builtin_amdgcn_s_sleep(1);
        if ((++sp & 255u) == 0u) { if (xb_ld(&bar[XB_TMO])) break; if (sp > XB_SPIN_CAP) { atomicAdd(&bar[XB_TMO], 1u); break; } }
    }
    nloc = mine > 0u ? mine : 1u; nx = cnt > 0u ? cnt : 1u;
}
__device__ __forceinline__ void xcd_barrier(const XcdBarrier& b, const bool leader  ) {
    asm volatile("s_waitcnt vmcnt(0)" ::: "memory");
    __syncthreads();
    if (leader) {
        unsigned* bar = b.bar;
        __builtin_amdgcn_s_waitcnt(0);
        unsigned nloc = b.st[0], nx = b.st[1];
        if (nloc == 0u) { xcd_barrier_complete(bar, b.x, nloc, nx); b.st[0] = nloc; b.st[1] = nx; }
        const unsigned old = xb_add(&bar[XB_XSUB(b.x)], 1u);
        const unsigned gen = old / nloc;
        if (old + 1u == (gen + 1u) * nloc) {
            __builtin_amdgcn_fence(__ATOMIC_RELEASE, "agent");
            asm volatile("s_waitcnt vmcnt(0)" ::: "memory");
            const unsigned og = xb_add(&bar[XB_TOP], 1u);
            const unsigned tg = og / nx;
            if (og + 1u == (tg + 1u) * nx) xb_add(&bar[XB_TOPGEN], 1u);
            else XB_SPIN(xb_ld(&bar[XB_TOPGEN]) == tg, bar);
            __builtin_amdgcn_fence(__ATOMIC_ACQUIRE, "agent");
            asm volatile("s_waitcnt vmcnt(0)" ::: "memory");
        } else {
            XB_SPIN(xb_ld(&bar[XB_TOPGEN]) == gen, bar);
            __builtin_amdgcn_fence(__ATOMIC_ACQUIRE, "agent");
            asm volatile("s_waitcnt vmcnt(0)" ::: "memory");
        }
    }
    __syncthreads();
}

template <int V> struct IntC { static constexpr int value = V; };
namespace pg8 {
constexpr int BM = 256, BK = 64, HALF = 128, HTB = HALF * BK * 2, STAGE_BYTES = 8 * HTB;
__host__ __device__ __forceinline__ int lds_byte(int r, int c) { const int st = (r >> 4) * 2 + (c >> 5), rr = r & 15, cc = c & 31, ob = rr * 64 + cc * 2; return st * 1024 + (ob ^ (((ob >> 9) & 1) << 5)); }
__host__ __device__ __forceinline__ void stage_rc(int b, int& R, int& C) { const int st = b / 1024, sb = b % 1024, swz = sb ^ (((sb >> 9) & 1) << 5); R = (st >> 1) * 16 + swz / 64; C = (st & 1) * 32 + (swz % 64) / 2; }
__host__ __device__ __forceinline__ int perm32(int rho) { const int n = rho >> 4, i = rho & 15; return 8 * (i >> 2) + 4 * n + (i & 3); }

struct Unit { const char* A; const char* B0; const char* B1; int pm, pn, aux; };

typedef int i32x4 __attribute__((ext_vector_type(4)));
template <class Epi, class Sched, bool KSPLIT, bool I8, bool GATHER = false>
__device__ __forceinline__ void gemm_phase_pipe(LAS unsigned char* lds, const int tid, const int Kb, const int pitchA, const int pitchB, const int ks, const Sched& S, const Epi& E) {
    const int wid = __builtin_amdgcn_readfirstlane(tid >> 6), lane = tid & 63, wr = wid >> 2, wc = wid & 3, fr = lane & 15, fq = lane >> 4;
    const int nt = Kb / 128;
    unsigned voffA[2], voffB[2];
#pragma unroll
    for (int i = 0; i < 2; ++i) { int R, C; stage_rc(tid * 16 + i * 8192, R, C); const int Rb = Epi::PERM ? ((R & ~31) + perm32(R & 31)) : R;
        voffA[i] = (unsigned)(R * pitchA + C * 2); voffB[i] = (unsigned)(Rb * pitchB + C * 2); }
    const size_t kstep = (size_t)128;
    const size_t hstepA = (size_t)HALF * pitchA, hstepB = (size_t)HALF * pitchB;
    const unsigned ldsw = (unsigned)wid * 1024u;
    const int aoff = lds_byte(wr * 64 + fr, fq * 8), boff = lds_byte(wc * 32 + fr, fq * 8);
#define PG8_SA(b, h) (((b) * 2 + (h)) * HTB)
#define PG8_SB(b, h) ((4 + (b) * 2 + (h)) * HTB)
#define PG8_STAGE(bufoff, gbase, voff) do { _Pragma("unroll") for (int _i = 0; _i < 2; ++_i) \
        __builtin_amdgcn_global_load_lds((const unsigned*)((const char*)(gbase) + (voff)[_i]), (LAS unsigned*)(lds + (bufoff) + ldsw + _i * 8192), 16, 0, 0); } while (0)
#define PG8_LDA(dst, b, h) do { _Pragma("unroll") for (int m = 0; m < 4; ++m) _Pragma("unroll") for (int k = 0; k < 2; ++k) dst[m][k] = *(const LAS bf16x8*)(lds + PG8_SA(b, h) + aoff + m * 2048 + k * 1024); } while (0)
#define PG8_LDB(dst, b, h) do { _Pragma("unroll") for (int n = 0; n < 2; ++n) _Pragma("unroll") for (int k = 0; k < 2; ++k) dst[n][k] = *(const LAS bf16x8*)(lds + PG8_SB(b, h) + boff + n * 2048 + k * 1024); } while (0)
#define PG8_MMA(ai, bj, At, Bt) do { __builtin_amdgcn_s_setprio(1); _Pragma("unroll") for (int m = 0; m < 4; ++m) _Pragma("unroll") for (int n = 0; n < 2; ++n) _Pragma("unroll") for (int k = 0; k < 2; ++k) { \
        if constexpr (I8) acc[ai][bj][m][n] = __builtin_bit_cast(f32x4, __builtin_amdgcn_mfma_i32_16x16x64_i8(__builtin_bit_cast(i32x4, Bt[n][k]), __builtin_bit_cast(i32x4, At[m][k]), __builtin_bit_cast(i32x4, acc[ai][bj][m][n]), 0, 0, 0)); \
        else acc[ai][bj][m][n] = __builtin_amdgcn_mfma_f32_16x16x32_bf16(Bt[n][k], At[m][k], acc[ai][bj][m][n], 0, 0, 0); } __builtin_amdgcn_s_setprio(0); } while (0)
#define PG8_WAIT_V(n) asm volatile("s_waitcnt vmcnt(" #n ")" ::: "memory")
#define PG8_WAIT_L(n) asm volatile("s_waitcnt lgkmcnt(" #n ")" ::: "memory")
#define PG8_BAR __builtin_amdgcn_s_barrier()
#define PG8_SCHED __builtin_amdgcn_sched_barrier(0)
#define PG8_STAGEA(bufoff, gptr, koff, h, VG) do { if constexpr (GATHER) { PG8_STAGE(bufoff, (const char*)S.abase() + (koff), VG[h]); } else { PG8_STAGE(bufoff, (gptr) + (h) * hstepA, voffA); } } while (0)
#define PG8_BPTR(u, tt) ((KSPLIT && (tt) >= ks) ? (u).B1 + (size_t)((tt) - ks) * kstep : (u).B0 + (size_t)(tt) * kstep)
    Unit cur, nxt; int ui = 0;
    if (!S.next(0, cur)) return;
    unsigned vgC[2][2], vgN[2][2]; int gR[2], gC2[2];
    if constexpr (GATHER) {
#pragma unroll
        for (int i = 0; i < 2; ++i) { int R, C; stage_rc(tid * 16 + i * 8192, R, C); gR[i] = R; gC2[i] = C * 2; }
#pragma unroll
        for (int h = 0; h < 2; ++h)
#pragma unroll
            for (int i = 0; i < 2; ++i) { vgC[h][i] = (unsigned)(S.arow(cur.pm * 256 + h * 128 + gR[i]) * pitchA + gC2[i]); vgN[h][i] = vgC[h][i]; }
    }
    f32x4 acc[2][2][4][2];
#pragma unroll
    for (int a = 0; a < 2; ++a)
#pragma unroll
        for (int b = 0; b < 2; ++b)
#pragma unroll
            for (int m = 0; m < 4; ++m)
#pragma unroll
                for (int n = 0; n < 2; ++n) acc[a][b][m][n] = (f32x4){0.f, 0.f, 0.f, 0.f};
    bf16x8 At[4][2], B0[2][2], B1[2][2];
    {
        const char* cA = cur.A; const char* cB = cur.B0;
        PG8_STAGE(PG8_SB(0, 0), cB, voffB); PG8_STAGE(PG8_SB(0, 1), cB + hstepB, voffB); PG8_STAGEA(PG8_SA(0, 0), cA, 0, 0, vgC); PG8_STAGEA(PG8_SA(0, 1), cA, 0, 1, vgC);
        if (wr == 1) PG8_BAR;
        PG8_WAIT_V(2); PG8_BAR;
        PG8_STAGE(PG8_SB(1, 0), cB + kstep, voffB); PG8_STAGEA(PG8_SA(1, 0), cA + kstep, kstep, 0, vgC); PG8_STAGE(PG8_SB(1, 1), cB + hstepB + kstep, voffB);
        PG8_WAIT_V(6); PG8_BAR;
    }
    for (;;) {
        const bool has_next = S.next(ui + 1, nxt);
        if (!has_next) nxt = cur;
        if constexpr (GATHER) { if (has_next) {
#pragma unroll
            for (int h = 0; h < 2; ++h)
#pragma unroll
                for (int i = 0; i < 2; ++i) vgN[h][i] = (unsigned)(S.arow(nxt.pm * 256 + h * 128 + gR[i]) * pitchA + gC2[i]); } }
        __builtin_assume(nt >= 2);
        for (int t = 0; t < nt; t += 2) {
            const bool last = (t == nt - 2);
            const char* a1 = cur.A + (size_t)(t + 1) * kstep;
            const char* a2 = last ? nxt.A : cur.A + (size_t)(t + 2) * kstep;
            const char* b2 = last ? nxt.B0 : PG8_BPTR(cur, t + 2);
            const char* a3 = a2 + kstep; const char* b3 = b2 + kstep;
            unsigned vgX[2][2]; size_t k1 = 0, k2 = 0;
            if constexpr (GATHER) { k1 = (size_t)(t + 1) * kstep;
                if (last) { k2 = 0;
#pragma unroll
                    for (int h = 0; h < 2; ++h) { vgX[h][0] = vgN[h][0]; vgX[h][1] = vgN[h][1]; } }
                else { k2 = (size_t)(t + 2) * kstep;
#pragma unroll
                    for (int h = 0; h < 2; ++h) { vgX[h][0] = vgC[h][0]; vgX[h][1] = vgC[h][1]; } } }
            PG8_LDB(B0, 0, 0); PG8_LDB(B1, 0, 1); PG8_SCHED; PG8_LDA(At, 0, 0); PG8_STAGEA(PG8_SA(1, 1), a1, k1, 1, vgC);
            PG8_WAIT_V(8); PG8_WAIT_L(0); PG8_BAR; PG8_MMA(0, 0, At, B0); PG8_MMA(0, 1, At, B1); PG8_BAR; PG8_SCHED;
            PG8_LDA(At, 0, 1); PG8_STAGE(PG8_SB(0, 0), b2, voffB); PG8_STAGE(PG8_SB(0, 1), b2 + hstepB, voffB); PG8_STAGEA(PG8_SA(0, 0), a2, k2, 0, vgX);
            PG8_WAIT_V(8); PG8_WAIT_L(0); PG8_BAR; PG8_MMA(1, 0, At, B0); PG8_MMA(1, 1, At, B1); PG8_BAR; PG8_SCHED;
            PG8_LDB(B0, 1, 0); PG8_LDB(B1, 1, 1); PG8_SCHED; PG8_LDA(At, 1, 0); PG8_STAGEA(PG8_SA(0, 1), a2, k2, 1, vgX);
            PG8_WAIT_V(8); PG8_WAIT_L(0); PG8_BAR; PG8_MMA(0, 0, At, B0); PG8_MMA(0, 1, At, B1); PG8_BAR; PG8_SCHED;
            PG8_LDA(At, 1, 1); PG8_STAGE(PG8_SB(1, 0), b3, voffB); PG8_STAGE(PG8_SB(1, 1), b3 + hstepB, voffB); PG8_STAGEA(PG8_SA(1, 0), a3, k2 + kstep, 0, vgX);
            PG8_WAIT_V(8); PG8_WAIT_L(0); PG8_BAR; PG8_MMA(1, 0, At, B0); PG8_MMA(1, 1, At, B1); PG8_BAR; PG8_SCHED;
        }
        if (wr == 0) PG8_BAR;
        if constexpr (I8) {
#pragma unroll
            for (int a = 0; a < 2; ++a)
#pragma unroll
                for (int b = 0; b < 2; ++b)
#pragma unroll
                    for (int m = 0; m < 4; ++m)
#pragma unroll
                        for (int n = 0; n < 2; ++n) { const i32x4 iv = __builtin_bit_cast(i32x4, acc[a][b][m][n]); acc[a][b][m][n] = (f32x4){(float)iv[0], (float)iv[1], (float)iv[2], (float)iv[3]}; }
        }
        E(acc, cur, wr, wc, fr, fq);
        if (!has_next) break;
#pragma unroll
        for (int a = 0; a < 2; ++a)
#pragma unroll
            for (int b = 0; b < 2; ++b)
#pragma unroll
                for (int m = 0; m < 4; ++m)
#pragma unroll
                    for (int n = 0; n < 2; ++n) acc[a][b][m][n] = (f32x4){0.f, 0.f, 0.f, 0.f};
        cur = nxt; ++ui;
        if constexpr (GATHER) {
#pragma unroll
            for (int h = 0; h < 2; ++h) { vgC[h][0] = vgN[h][0]; vgC[h][1] = vgN[h][1]; } }
        if (wr == 1) PG8_BAR;
    }
    PG8_WAIT_V(0);
    PG8_BAR;
#undef PG8_SA
#undef PG8_SB
#undef PG8_STAGE
#undef PG8_LDA
#undef PG8_LDB
#undef PG8_MMA
#undef PG8_WAIT_V
#undef PG8_WAIT_L
#undef PG8_BAR
#undef PG8_SCHED
#undef PG8_BPTR
#undef PG8_STAGEA
}
template <class Epi, class Sched, bool KSPLIT, bool I8, bool GATHER = false>
__device__ __forceinline__ void gemm_phase(LAS unsigned char* lds, const int tid, const int Kbc, const int pitchA, const int pitchB, const int ks, const Sched& S, const Epi& E) {
    int Kb = Kbc; asm volatile("" : "+s"(Kb));
    gemm_phase_pipe<Epi, Sched, KSPLIT, I8, GATHER>(lds, tid, Kb, pitchA, pitchB, ks, S, E);
}
}
using pg8::Unit;

__device__ __forceinline__ int vcu_of(int bx, int G) { return (G % 8 == 0) ? (bx % 8) * (G / 8) + bx / 8 : bx; }

struct SchedProj {
    const char* A; const char* B; int G, c;
    __device__ __forceinline__ bool next(int i, Unit& u) const {
        const int L = i * G + c; if (L >= 2048) return false;
        const int blk = L >> 5, w = L & 31, pml = w & 7, pnl = w >> 3, bm = blk & 15, sel = blk >> 4;
        const int pm = bm * 8 + pml, ct = (sel == 0 ? 0 : sel == 1 ? 4 : sel == 2 ? 12 : 16) + pnl;
        u.A = A + (size_t)pm * 256 * D; u.B0 = B + (size_t)ct * 256 * D; u.B1 = u.B0; u.pm = pm; u.pn = pnl; u.aux = sel; return true;
    }
};
struct SchedProjT {
    const char* W; const char* Hn; int G, c;
    __device__ __forceinline__ bool next(int i, Unit& u) const {
        const int L = i * G + c; if (L >= 1024) return false;
        const int blk = L >> 5, w = L & 31, ptl = w & 7, pfl = w >> 3, bt = blk & 15, type = (blk >> 4) + 1;
        const int pt = bt * 8 + ptl, frow = (type == 0 ? 1024 : type == 1 ? 2048 : 5120) + 256 * pfl;
        u.A = W + (size_t)frow * D; u.B0 = Hn + (size_t)pt * 256 * D; u.B1 = u.B0; u.pm = pfl; u.pn = pt; u.aux = type; return true;
    }
};
struct SchedKV {
    const char* VT; const char* KT; int G, c;
    __device__ __forceinline__ bool next(int i, Unit& u) const {
        const int L = i * G + c; if (L >= 1024) return false;
        const int ch = L & 127, h = (L >> 7) & 3, b = L >> 9;
        const size_t off = ((size_t)(b * 128 + ch) * 1024 + (size_t)(h * 256)) * 256;
        u.A = VT + off; u.B0 = KT + off; u.B1 = u.B0; u.pm = L; u.pn = 0; u.aux = 0; return true;
    }
};
struct SchedOut {
    const char* A; const char* B; int G, c;
    __device__ __forceinline__ bool next(int i, Unit& u) const {
        const int L = i * G + c; if (L >= 1024) return false;
        const int blk = L >> 5, w = L & 31, pml = w & 7, pnl = w >> 3, bm = blk & 15, bn = blk >> 4;
        const int pm = bm * 8 + pml, pn = bn * 4 + pnl;
        u.A = A + (size_t)pm * 256 * D; u.B0 = B + (size_t)pn * 256 * D; u.B1 = u.B0; u.pm = pm; u.pn = pn; u.aux = 0; return true;
    }
};
__device__ __forceinline__ void bucket_experts(int bucket, int& elo, int& ehi) {
    const int gq = bucket / 6, p = bucket - gq * 6; int lo, hi;
    if (p < 3) { lo = 0; hi = p + 1; } else if (p < 5) { lo = 1; hi = p - 1; } else { lo = 2; hi = 3; }
    elo = gq * 4 + lo; ehi = gq * 4 + hi;
}
struct SchedUp {
    const char* A; const char* W13; const LAS int* tt; int G, c; const int* r2t;
    __device__ __forceinline__ const char* abase() const { return A; }
    __device__ __forceinline__ int arow(int row) const { const int b = tt[64 + (row >> 8)], pos = row - tt[1 + b]; return pos < tt[320 + b] ? r2t[(b << 15) + pos] : 0; }
    __device__ __forceinline__ bool next(int i, Unit& u) const {
        const int L = i * G + c; const int T = __builtin_amdgcn_readfirstlane(tt[0]); if (L >= T * 8) return false;
        const int tile = L >> 3, pn = L & 7, bucket = __builtin_amdgcn_readfirstlane(tt[64 + tile]); int elo, ehi; bucket_experts(bucket, elo, ehi);
        const int e = (pn >> 2) ? ehi : elo, jb = pn & 3;
        u.A = A; u.B0 = W13 + ((size_t)e * 1024 + (size_t)jb * 256) * D; u.B1 = u.B0; u.pm = tile; u.pn = pn; u.aux = e; return true;
    }
};
struct SchedDown {
    const char* A; const char* W2; const LAS int* tt; int G, c;
    __device__ __forceinline__ bool next(int i, Unit& u) const {
        const int L = i * G + c; const int T = __builtin_amdgcn_readfirstlane(tt[0]); if (L >= T * 8) return false;
        const int tile = L >> 3, pn = L & 7, bucket = __builtin_amdgcn_readfirstlane(tt[64 + tile]); int elo, ehi; bucket_experts(bucket, elo, ehi);
        u.A = A + (size_t)tile * 256 * 1024 * 2; u.B0 = W2 + ((size_t)elo * 2048 + (size_t)pn * 256) * FF * 2; u.B1 = W2 + ((size_t)ehi * 2048 + (size_t)pn * 256) * FF * 2;
        u.pm = tile; u.pn = pn; u.aux = 0; return true;
    }
};

struct EpiProj {
    static constexpr bool PERM = true;
    unsigned char* ws; LAS unsigned char* kts;
    __device__ __forceinline__ void operator()(const f32x4 (&acc)[2][2][4][2], const Unit& u, int wr, int wc, int fr, int fq) const {
        const int sel = u.aux;
        bf16_t* O = (bf16_t*)(ws + WS_Q + (size_t)sel * (64 * MiB));
        LAS unsigned char* scw = kts + (wr * 4 + wc) * 2048;
        const unsigned* rot = (const unsigned*)(ws + WS_COS);
        const int j0 = wc * 32 + 8 * fq;
        const float* hsc = (const float*)(ws + WS_HSC);
        const float* wsc = (const float*)(ws + WS_WSC_IN) + ((sel == 0 ? 0 : sel == 1 ? 4 : sel == 2 ? 12 : 16) + u.pn) * 256 + j0;
        const int rowb = u.pm * 256 + wr * 64 + fr;
        f32x4 sb[2][2]; float sa[2][4];
#pragma unroll
        for (int bj = 0; bj < 2; ++bj)
#pragma unroll
            for (int n = 0; n < 2; ++n) sb[bj][n] = *(const f32x4*)(wsc + bj * 128 + 4 * n);
#pragma unroll
        for (int ai = 0; ai < 2; ++ai)
#pragma unroll
            for (int m = 0; m < 4; ++m) sa[ai][m] = hsc[rowb + ai * 128 + m * 16];
        if (sel < 2) {
            const float lgk = log2_gamma(u.pn);
#pragma unroll
            for (int ai = 0; ai < 2; ++ai) {
                u32x4 rt[4][2];
#pragma unroll
                for (int m = 0; m < 4; ++m)
#pragma unroll
                    for (int n = 0; n < 2; ++n) rt[m][n] = *(const u32x4*)((const char*)rot + (unsigned)((rowb + ai * 128 + m * 16) * 128 + j0 + 4 * n) * 4u);
                asm volatile("" ::: "memory");
#pragma unroll
                for (int m = 0; m < 4; ++m) {
                    const int row = rowb + ai * 128 + m * 16;
                    bf16_t* orow = (bf16_t*)((char*)O + (unsigned)(row * 1024 + u.pn * 256 + j0) * 2u);
                    const float sc = (sel == 1 ? 0.0625f : 1.0f) * sa[ai][m];
                    u32x4 w1, w2;
#pragma unroll
                    for (int n = 0; n < 2; ++n) {
                        const u32x4 r4 = rt[m][n];
                        const f32x4 c0 = {bflo(r4.x), bflo(r4.y), bflo(r4.z), bflo(r4.w)}, s0 = {bfhi(r4.x), bfhi(r4.y), bfhi(r4.z), bfhi(r4.w)};
                        const f32x4 x1 = acc[ai][0][m][n] * sb[0][n] * sc, x2 = acc[ai][1][m][n] * sb[1][n] * sc;
                        const f32x4 o1 = x1 * c0 - x2 * s0, o2 = x2 * c0 + x1 * s0;
                        if (n == 0) { w1.x = pk2(o1[0], o1[1]); w1.y = pk2(o1[2], o1[3]); w2.x = pk2(o2[0], o2[1]); w2.y = pk2(o2[2], o2[3]); }
                        else        { w1.z = pk2(o1[0], o1[1]); w1.w = pk2(o1[2], o1[3]); w2.z = pk2(o2[0], o2[1]); w2.w = pk2(o2[2], o2[3]); }
                    }
                    *(u32x4*)(orow) = w1; *(u32x4*)(orow + 128) = w2;
                    if (sel == 1) {
                        const float kd = __builtin_amdgcn_exp2f(lgk * (float)(127 - (row & 127)));
                        const unsigned wk1[4] = {w1.x, w1.y, w1.z, w1.w}, wk2[4] = {w2.x, w2.y, w2.z, w2.w};
#pragma unroll
                        for (int q = 0; q < 4; ++q) {
                            const unsigned a = pk2(bflo(wk1[q]) * kd, bfhi(wk1[q]) * kd), b = pk2(bflo(wk2[q]) * kd, bfhi(wk2[q]) * kd);
                            LAS bf16_t* p1 = (LAS bf16_t*)(scw + ((8 * fq + 2 * q) * 16 + fr) * 2); LAS bf16_t* p2 = (LAS bf16_t*)(scw + 1024 + ((8 * fq + 2 * q) * 16 + fr) * 2);
                            p1[0] = (bf16_t)(a & 0xffffu); p1[16] = (bf16_t)(a >> 16); p2[0] = (bf16_t)(b & 0xffffu); p2[16] = (bf16_t)(b >> 16); }
                        asm volatile("s_waitcnt lgkmcnt(0)" ::: "memory");
                        const int lane = fq * 16 + fr, ft = lane >> 1, th = lane & 1;
                        const u32x4 t1 = *(const LAS u32x4*)(scw + ft * 32 + th * 16), t2 = *(const LAS u32x4*)(scw + 1024 + ft * 32 + th * 16);
                        const int tokb = u.pm * 256 + ai * 128 + wr * 64 + m * 16 + 8 * th;
                        bf16_t* kt = (bf16_t*)(ws + WS_KT);
                        *(u32x4*)((char*)kt + (unsigned)(((tokb >> 7) * 1024 + u.pn * 256 + wc * 32 + ft) * 256 + (tokb & 127) * 2)) = t1;
                        *(u32x4*)((char*)kt + (unsigned)(((tokb >> 7) * 1024 + u.pn * 256 + 128 + wc * 32 + ft) * 256 + (tokb & 127) * 2)) = t2;
                        asm volatile("s_waitcnt lgkmcnt(0)" ::: "memory");
                    }
                }
                asm volatile("" ::: "memory");
            }
        } else {
#pragma unroll
            for (int ai = 0; ai < 2; ++ai)
#pragma unroll
                for (int m = 0; m < 4; ++m) {
                    const int row = rowb + ai * 128 + m * 16;
                    bf16_t* orow = (bf16_t*)((char*)O + (unsigned)(row * 1024 + u.pn * 256 + j0) * 2u);
#pragma unroll
                    for (int bj = 0; bj < 2; ++bj) { f32x4 v0 = acc[ai][bj][m][0] * sb[bj][0] * sa[ai][m], v1 = acc[ai][bj][m][1] * sb[bj][1] * sa[ai][m];
#pragma unroll
                        for (int i = 0; i < 4; ++i) { v0[i] = sel == 2 ? siluf_(v0[i]) : gelu_tanh(v0[i]); v1[i] = sel == 2 ? siluf_(v1[i]) : gelu_tanh(v1[i]); }
                        u32x4 w; w.x = pk2(v0[0], v0[1]); w.y = pk2(v0[2], v0[3]); w.z = pk2(v1[0], v1[1]); w.w = pk2(v1[2], v1[3]);
                        *(u32x4*)(orow + bj * 128) = w; }
                }
        }
    }
};
struct EpiProjT {
    static constexpr bool PERM = true;
    unsigned char* ws;
    __device__ __forceinline__ void operator()(const f32x4 (&acc)[2][2][4][2], const Unit& u, int wr, int wc, int fr, int fq) const {
        const int type = u.aux;
        bf16_t* O = (bf16_t*)(ws + WS_KT + (size_t)type * (64 * MiB));
        const int t0 = u.pn * 256 + wc * 32 + 8 * fq;
        const float* hsc = (const float*)(ws + WS_HSC) + t0;
        const float* wsc = (const float*)(ws + WS_WSC_IN) + (type == 1 ? 2048 : 5120) + u.pm * 256 + wr * 64 + fr;
        f32x4 sa[2][2]; float sw[2][4];
#pragma unroll
        for (int bj = 0; bj < 2; ++bj)
#pragma unroll
            for (int n = 0; n < 2; ++n) sa[bj][n] = *(const f32x4*)(hsc + bj * 128 + 4 * n);
#pragma unroll
        for (int ai = 0; ai < 2; ++ai)
#pragma unroll
            for (int m = 0; m < 4; ++m) sw[ai][m] = wsc[ai * 128 + m * 16];
#pragma unroll
        for (int ai = 0; ai < 2; ++ai)
#pragma unroll
            for (int m = 0; m < 4; ++m) {
                const int f = u.pm * 256 + ai * 128 + wr * 64 + m * 16 + fr;
#pragma unroll
                for (int bj = 0; bj < 2; ++bj) { f32x4 v0 = acc[ai][bj][m][0] * sa[bj][0] * sw[ai][m], v1 = acc[ai][bj][m][1] * sa[bj][1] * sw[ai][m];
                    if (type == 2) {
#pragma unroll
                        for (int i = 0; i < 4; ++i) { v0[i] = gelu_tanh(v0[i]); v1[i] = gelu_tanh(v1[i]); } }
                    u32x4 w; w.x = pk2(v0[0], v0[1]); w.y = pk2(v0[2], v0[3]); w.z = pk2(v1[0], v1[1]); w.w = pk2(v1[2], v1[3]);
                    *(u32x4*)((char*)O + (unsigned)((((t0 >> 7) + bj) * 1024 + f) * 256 + (t0 & 127) * 2)) = w; }
            }
    }
};
struct EpiKV {
    static constexpr bool PERM = true;
    unsigned char* O;
    __device__ __forceinline__ void operator()(const f32x4 (&acc)[2][2][4][2], const Unit& u, int wr, int wc, int fr, int fq) const {
        unsigned char* base = O + (size_t)u.pm * 65536;
#pragma unroll
        for (int ai = 0; ai < 2; ++ai)
#pragma unroll
            for (int m = 0; m < 4; ++m) { unsigned char* rowp = base + (ai * 128 + wr * 64 + m * 16 + fr) * 256 + wc * 32 + 8 * fq;
#pragma unroll
                for (int bj = 0; bj < 2; ++bj) *(u32x2*)(rowp + bj * 128) = f8pack(acc[ai][bj][m][0], acc[ai][bj][m][1]); }
    }
};
template <bool IN_F32> struct EpiOut {
    static constexpr bool PERM = true;
    const void* xi; bf16_t* xo; const float* gate; const float* hsc; const float* wsc;
    __device__ __forceinline__ void operator()(const f32x4 (&acc)[2][2][4][2], const Unit& u, int wr, int wc, int fr, int fq) const {
        const int b = (u.pm * 256) >> 14; const float* gb = gate + (size_t)b * 12288;
        const int col0 = u.pn * 256 + wc * 32 + 8 * fq;
        u32x2 gvp[2][2]; float sa[2][4];
#pragma unroll
        for (int bj = 0; bj < 2; ++bj)
#pragma unroll
            for (int n = 0; n < 2; ++n) { const f32x4 gq = *(const f32x4*)(gb + col0 + bj * 128 + n * 4) * *(const f32x4*)(wsc + col0 + bj * 128 + n * 4); gvp[bj][n].x = pk2(gq[0], gq[1]); gvp[bj][n].y = pk2(gq[2], gq[3]); }
#define GV(bj, n) ((f32x4){bflo(gvp[bj][n].x), bfhi(gvp[bj][n].x), bflo(gvp[bj][n].y), bfhi(gvp[bj][n].y)})
#pragma unroll
        for (int ai = 0; ai < 2; ++ai)
#pragma unroll
            for (int m = 0; m < 4; ++m) sa[ai][m] = hsc[u.pm * 256 + ai * 128 + wr * 64 + m * 16 + fr];
        const unsigned off0 = (unsigned)((u.pm * 256 + wr * 64 + fr) * D + col0);
        if (IN_F32) {
#pragma unroll
            for (int ai = 0; ai < 2; ++ai) {
                f32x4 xr[4][2][2];
#pragma unroll
                for (int m = 0; m < 4; ++m)
#pragma unroll
                    for (int bj = 0; bj < 2; ++bj) { const float* xp = (const float*)xi + off0 + (ai * 128 + m * 16) * D + bj * 128; xr[m][bj][0] = *(const f32x4*)xp; xr[m][bj][1] = *(const f32x4*)(xp + 4); }
#pragma unroll
                for (int m = 0; m < 4; ++m)
#pragma unroll
                    for (int bj = 0; bj < 2; ++bj) { const f32x4 o0 = xr[m][bj][0] + GV(bj, 0) * (acc[ai][bj][m][0] * sa[ai][m]), o1 = xr[m][bj][1] + GV(bj, 1) * (acc[ai][bj][m][1] * sa[ai][m]);
                        u32x4 w; w.x = pk2(o0[0], o0[1]); w.y = pk2(o0[2], o0[3]); w.z = pk2(o1[0], o1[1]); w.w = pk2(o1[2], o1[3]);
                        *(u32x4*)(xo + off0 + (ai * 128 + m * 16) * D + bj * 128) = w; }
                asm volatile("" ::: "memory");
            }
        } else {
            u32x4 xr[2][4][2];
#pragma unroll
            for (int ai = 0; ai < 2; ++ai)
#pragma unroll
                for (int m = 0; m < 4; ++m)
#pragma unroll
                    for (int bj = 0; bj < 2; ++bj) xr[ai][m][bj] = *(const u32x4*)((const bf16_t*)xi + off0 + (ai * 128 + m * 16) * D + bj * 128);
#pragma unroll
            for (int ai = 0; ai < 2; ++ai)
#pragma unroll
                for (int m = 0; m < 4; ++m)
#pragma unroll
                    for (int bj = 0; bj < 2; ++bj) { const u32x4 xw = xr[ai][m][bj];
                        const f32x4 x0 = {bflo(xw.x), bfhi(xw.x), bflo(xw.y), bfhi(xw.y)}, x1v = {bflo(xw.z), bfhi(xw.z), bflo(xw.w), bfhi(xw.w)};
                        const f32x4 o0 = x0 + GV(bj, 0) * (acc[ai][bj][m][0] * sa[ai][m]), o1 = x1v + GV(bj, 1) * (acc[ai][bj][m][1] * sa[ai][m]);
                        u32x4 w; w.x = pk2(o0[0], o0[1]); w.y = pk2(o0[2], o0[3]); w.z = pk2(o1[0], o1[1]); w.w = pk2(o1[2], o1[3]);
                        *(u32x4*)(xo + off0 + (ai * 128 + m * 16) * D + bj * 128) = w; }
        }
    }
};
#undef GV
struct EpiUp {
    static constexpr bool PERM = true;
    bf16_t* HH; const float* rowgate; const float* rowsc; const float* wsc13; const LAS int* tt;
    __device__ __forceinline__ void operator()(const f32x4 (&acc)[2][2][4][2], const Unit& u, int wr, int wc, int fr, int fq) const {
        const int es = u.pn >> 2, jb = u.pn & 3;
        const float* wsc = wsc13 + (size_t)u.aux * 1024 + jb * 256 + wc * 32 + 8 * fq;
        f32x4 sb[2][2];
#pragma unroll
        for (int bj = 0; bj < 2; ++bj)
#pragma unroll
            for (int n = 0; n < 2; ++n) sb[bj][n] = *(const f32x4*)(wsc + bj * 128 + 4 * n);
        float gg[2][4], ss[2][4];
        const int bkt = __builtin_amdgcn_readfirstlane(tt[64 + u.pm]), bidx0 = (bkt << 15) + u.pm * 256 - __builtin_amdgcn_readfirstlane(tt[1 + bkt]);
#pragma unroll
        for (int ai = 0; ai < 2; ++ai)
#pragma unroll
            for (int m = 0; m < 4; ++m) { const int bi = bidx0 + ai * 128 + wr * 64 + m * 16 + fr; gg[ai][m] = rowgate[(size_t)bi * 2 + es]; ss[ai][m] = rowsc[bi]; }
#pragma unroll
        for (int ai = 0; ai < 2; ++ai)
#pragma unroll
            for (int m = 0; m < 4; ++m) { const int row = u.pm * 256 + ai * 128 + wr * 64 + m * 16 + fr;
                const float g = gg[ai][m], sa = ss[ai][m];
                const f32x4 a10 = acc[ai][0][m][0] * sb[0][0] * sa, a11 = acc[ai][0][m][1] * sb[0][1] * sa, a30 = acc[ai][1][m][0] * sb[1][0] * sa, a31 = acc[ai][1][m][1] * sb[1][1] * sa;
                f32x4 h0, h1;
#pragma unroll
                for (int i = 0; i < 4; ++i) { h0[i] = siluf_(a10[i]) * a30[i] * g; h1[i] = siluf_(a11[i]) * a31[i] * g; }
                u32x4 w; w.x = pk2(h0[0], h0[1]); w.y = pk2(h0[2], h0[3]); w.z = pk2(h1[0], h1[1]); w.w = pk2(h1[2], h1[3]);
                *(u32x4*)(HH + (size_t)row * 1024 + es * 512 + jb * 128 + wc * 32 + 8 * fq) = w; }
    }
};
struct EpiDown {
    static constexpr bool PERM = true;
    const bf16_t* xi; bf16_t* xo; const LAS float* gate; const int* row2tok; const LAS int* tt;
    __device__ __forceinline__ void operator()(const f32x4 (&acc)[2][2][4][2], const Unit& u, int wr, int wc, int fr, int fq) const {
        const int col0 = u.pn * 256 + wc * 32 + 8 * fq;
        const int bkt = __builtin_amdgcn_readfirstlane(tt[64 + u.pm]), pos0 = u.pm * 256 - __builtin_amdgcn_readfirstlane(tt[1 + bkt]), bcnt = __builtin_amdgcn_readfirstlane(tt[320 + bkt]);
        int tk[2][4];
#pragma unroll
        for (int ai = 0; ai < 2; ++ai)
#pragma unroll
            for (int m = 0; m < 4; ++m) { const int pos = pos0 + ai * 128 + wr * 64 + m * 16 + fr; tk[ai][m] = pos < bcnt ? row2tok[(bkt << 15) + pos] : -1; }
        u32x4 xr[2][4][2];
#pragma unroll
        for (int ai = 0; ai < 2; ++ai)
#pragma unroll
            for (int m = 0; m < 4; ++m) { const unsigned off = (unsigned)((tk[ai][m] < 0 ? 0 : tk[ai][m]) * D + col0);
#pragma unroll
                for (int bj = 0; bj < 2; ++bj) xr[ai][m][bj] = *(const u32x4*)(xi + off + bj * 128); }
#pragma unroll
        for (int ai = 0; ai < 2; ++ai)
#pragma unroll
            for (int m = 0; m < 4; ++m) { const int tok = tk[ai][m];
                if (tok >= 0) { const bool b1 = (tok >> 14) != 0; const unsigned off = (unsigned)(tok * D + col0);
#pragma unroll
                    for (int bj = 0; bj < 2; ++bj) { const u32x4 xw = xr[ai][m][bj]; const LAS float* gp = gate + (b1 ? 2048 : 0) + col0 + bj * 128; const f32x4 g0 = *(const LAS f32x4*)gp, g1 = *(const LAS f32x4*)(gp + 4);
                        const f32x4 x0 = {bflo(xw.x), bfhi(xw.x), bflo(xw.y), bfhi(xw.y)}, x1v = {bflo(xw.z), bfhi(xw.z), bflo(xw.w), bfhi(xw.w)};
                        const f32x4 o0 = x0 + g0 * acc[ai][bj][m][0], o1 = x1v + g1 * acc[ai][bj][m][1];
                        u32x4 w; w.x = pk2(o0[0], o0[1]); w.y = pk2(o0[2], o0[3]); w.z = pk2(o1[0], o1[1]); w.w = pk2(o1[2], o1[3]);
                        *(u32x4*)(xo + off + bj * 128) = w; } } }
    }
};

struct Args { const void* in[18]; float* out; unsigned char* ws; int ph_lo, ph_hi, li, pad; };
enum { I_X = 0, I_C, I_POS, I_WADA, I_BADA, I_N1W, I_N2W, I_WIN, I_WOUT, I_RNW, I_SGW, I_SGB, I_WR, I_RB, I_W1, I_W3, I_W2, I_FNW };

__device__ __forceinline__ const void* kargp(int idx) {
    int off = idx * 8; asm volatile("" : "+s"(off));
    typedef const void* cvp;
    const __attribute__((address_space(4))) char* k = (const __attribute__((address_space(4))) char*)__builtin_amdgcn_kernarg_segment_ptr();
    const cvp pp = *(const __attribute__((address_space(4))) cvp*)(k + off);
    return (const void*)(GAS const void*)pp;
}
struct Frame {
    LAS unsigned char* lds; int tid, lane, wave, G, vcu; unsigned char* ws;
};

__device__ __forceinline__ void transpose_item(const float* W, int ldw, int k0, int n0, bf16_t* dst, int ldd, LAS float* scr, int lane) {
#pragma unroll 8
    for (int i = 0; i < 32; ++i) { const int kk = 2 * i + (lane >> 5); scr[kk * 33 + (lane & 31)] = W[(size_t)(k0 + kk) * ldw + n0 + (lane & 31)]; }
    asm volatile("s_waitcnt lgkmcnt(0)" ::: "memory");
    const int c = lane & 7;
#pragma unroll
    for (int j = 0; j < 4; ++j) { const int n = (lane >> 3) + 8 * j; const LAS float* s = scr + (8 * c) * 33 + n;
        u32x4 o; o.x = pk2(s[0 * 33], s[1 * 33]); o.y = pk2(s[2 * 33], s[3 * 33]); o.z = pk2(s[4 * 33], s[5 * 33]); o.w = pk2(s[6 * 33], s[7 * 33]);
        *(u32x4*)(dst + (size_t)n * ldd + k0 + 8 * c) = o; }
    asm volatile("s_waitcnt lgkmcnt(0)" ::: "memory");
}
__device__ __forceinline__ void convert_weights(Frame& F, const Args& a, int layer) {
    LAS float* scr = (LAS float*)(F.lds + F.wave * 16384);
    LAS float* wmax = (LAS float*)(F.lds + KTS_OFF + 16384);
    const int gw = F.vcu * NWAVES + F.wave, NGW = F.G * NWAVES;
    const float* w_in = (const float*)kargp(I_WIN) + (size_t)layer * D * INC;
    const float* w_out = (const float*)kargp(I_WOUT) + (size_t)layer * D * D;
    const float* w1 = (const float*)kargp(I_W1) + (size_t)layer * NE * D * FF;
    const float* w3 = (const float*)kargp(I_W3) + (size_t)layer * NE * D * FF;
    const float* w2 = (const float*)kargp(I_W2) + (size_t)layer * NE * FF * D;
    signed char* win_q = (signed char*)(F.ws + WS_WIN); signed char* wout_q = (signed char*)(F.ws + WS_WOUT); signed char* w13_q = (signed char*)(F.ws + WS_W13); bf16_t* w2_t = (bf16_t*)(F.ws + WS_W2);
    float* wsc_in = (float*)(F.ws + WS_WSC_IN); float* wsc_13 = (float*)(F.ws + WS_WSC_13); float* wsc_out = (float*)(F.ws + WS_WSC_OUT);
    constexpr int Q_IN = INC / 32, Q_E = FF / 32, Q_OUT = D / 32, NQ = Q_IN + 2 * NE * Q_E + Q_OUT;
    const int c = F.lane & 31, hf = F.lane >> 5, w = F.wave;
    for (int it = F.vcu; it < NQ; it += F.G) {
        const float* W; int ldw, n0; signed char* dst; float* scale;
        if (it < Q_IN) { W = w_in; ldw = INC; n0 = it * 32; dst = win_q + (size_t)n0 * D; scale = wsc_in + n0; }
        else if (it >= Q_IN + 2 * NE * Q_E) { W = w_out; ldw = D; n0 = (it - Q_IN - 2 * NE * Q_E) * 32; dst = wout_q + (size_t)n0 * D; scale = wsc_out + n0; }
        else { int r = it - Q_IN; const int which = r / (NE * Q_E); r -= which * NE * Q_E; const int e = r / Q_E; n0 = (r - e * Q_E) * 32;
            const int drow = e * 1024 + (n0 >> 7) * 256 + which * 128 + (n0 & 127);
            W = (which ? w3 : w1) + (size_t)e * D * FF; ldw = FF; dst = w13_q + (size_t)drow * D; scale = wsc_13 + drow; }
        float v[4][32]; float am = 0.f;
        const float* wp = W + (size_t)(256 * w + hf) * ldw + n0 + c;
#pragma unroll
        for (int t = 0; t < 4; ++t)
#pragma unroll
            for (int i = 0; i < 32; ++i) v[t][i] = wp[(size_t)(64 * t + 2 * i) * ldw];
#pragma unroll
        for (int t = 0; t < 4; ++t)
#pragma unroll
            for (int i = 0; i < 32; ++i) am = fmaxf(am, fabsf(v[t][i]));
        am = fmaxf(am, __shfl_xor(am, 32));
        if (F.lane < 32) wmax[w * 32 + c] = am;
        __syncthreads();
        float cm = 1e-30f;
#pragma unroll
        for (int ww = 0; ww < 8; ++ww) cm = fmaxf(cm, wmax[ww * 32 + c]);
        const float inv = 127.0f / cm;
        if (w == 0 && F.lane < 32) scale[c] = cm * (1.0f / 127.0f);
#pragma unroll
        for (int t = 0; t < 4; ++t) {
#pragma unroll
            for (int i = 0; i < 32; ++i) scr[(2 * i + hf) * 33 + c] = v[t][i];
            asm volatile("s_waitcnt lgkmcnt(0)" ::: "memory");
            const LAS float* sp = scr + (32 * hf) * 33 + c;
            u32x4 o0, o1;
            o0.x = q4((f32x4){sp[0 * 33], sp[1 * 33], sp[2 * 33], sp[3 * 33]} * inv); o0.y = q4((f32x4){sp[4 * 33], sp[5 * 33], sp[6 * 33], sp[7 * 33]} * inv);
            o0.z = q4((f32x4){sp[8 * 33], sp[9 * 33], sp[10 * 33], sp[11 * 33]} * inv); o0.w = q4((f32x4){sp[12 * 33], sp[13 * 33], sp[14 * 33], sp[15 * 33]} * inv);
            o1.x = q4((f32x4){sp[16 * 33], sp[17 * 33], sp[18 * 33], sp[19 * 33]} * inv); o1.y = q4((f32x4){sp[20 * 33], sp[21 * 33], sp[22 * 33], sp[23 * 33]} * inv);
            o1.z = q4((f32x4){sp[24 * 33], sp[25 * 33], sp[26 * 33], sp[27 * 33]} * inv); o1.w = q4((f32x4){sp[28 * 33], sp[29 * 33], sp[30 * 33], sp[31 * 33]} * inv);
            signed char* dp = dst + (size_t)c * D + 256 * w + 64 * t + 32 * hf;
            *(u32x4*)dp = o0; *(u32x4*)(dp + 16) = o1;
            asm volatile("s_waitcnt lgkmcnt(0)" ::: "memory");
        }
        __syncthreads();
    }
    constexpr int I_E2 = (FF / 64) * (D / 32);
    constexpr int NIT = NE * I_E2;
    for (int it = gw; it < NIT; it += NGW) {
        int r = it;
        { const int e = r / I_E2; r -= e * I_E2; const int nb = D / 32, kb = r / nb, n0 = (r % nb) * 32;
            transpose_item(w2 + (size_t)e * FF * D, D, kb * 64, n0, w2_t + ((size_t)e * 2048 + n0) * FF, FF, scr, F.lane); }
    }
}
__device__ __forceinline__ void p0_prologue(Frame& F, const Args& a) {
    const int gt = F.vcu * NTHR + F.tid, NGT = F.G * NTHR;
    for (int step = 0; step < 2; ++step) {
    if ((step ^ (F.vcu & 1)) == 0) {
    { const int* pos = (const int*)kargp(I_POS); unsigned* rot = (unsigned*)(F.ws + WS_COS);
      for (int idx = gt; idx < NTOK * 128; idx += NGT) { const int tok = idx >> 7, j = idx & 127;
          const float inv = exp2f(-(float)j * (13.287712379549449f / 128.0f));
          const double rev = (double)pos[tok] * (double)inv * 0.15915494309189535; const float fr = (float)(rev - __builtin_rint(rev));
          rot[idx] = pk2(__builtin_amdgcn_cosf(fr), __builtin_amdgcn_sinf(fr)); } }
    { const float* wr = (const float*)kargp(I_WR); bf16_t* wrt = (bf16_t*)(F.ws + WS_WRT);
      for (int idx = gt; idx < NE * D; idx += NGT) { const int e = idx >> 11, k = idx & 2047; wrt[idx] = (bf16_t)f2bf(wr[k * NE + e]); }
      const float* sw = (const float*)kargp(I_SGW); bf16_t* swb = (bf16_t*)(F.ws + WS_SGW);
      for (int idx = gt; idx < 2 * SGG * CH * CH; idx += NGT) { const int m = idx & 127, n = (idx >> 7) & 127; swb[idx] = (m <= n) ? (bf16_t)f2bf(sw[idx]) : (bf16_t)0; } }
    } else {
    { LAS float* cact = (LAS float*)F.lds; LAS float* red = (LAS float*)(F.lds + 16384);
      const float* cc = (const float*)kargp(I_C);
      for (int i = F.tid; i < NB * D; i += NTHR) cact[i] = siluf_(cc[i]);
      __syncthreads();
      for (int cb = F.vcu; cb < 256; cb += F.G) {
          const int col0 = cb * 96, layer = col0 / 12288, cl0 = col0 - layer * 12288;
          const float* wa = (const float*)kargp(I_WADA) + (size_t)layer * D * 12288;
          if (F.tid < 504) { const int cg = F.tid % 24, kp = F.tid / 24; f32x4 s0 = {0.f, 0.f, 0.f, 0.f}, s1 = {0.f, 0.f, 0.f, 0.f};
              const int k0 = kp * 98, k1 = k0 + 98 < D ? k0 + 98 : D;
#pragma unroll 14
              for (int k = k0; k < k1; ++k) { const f32x4 w = *(const f32x4*)(wa + (size_t)k * 12288 + cl0 + 4 * cg); s0 += w * cact[k]; s1 += w * cact[D + k]; }
              *(LAS f32x4*)(red + ((kp * 24 + cg) * 2 + 0) * 4) = s0; *(LAS f32x4*)(red + ((kp * 24 + cg) * 2 + 1) * 4) = s1; }
          __syncthreads();
          if (F.tid < 192) { const int i = F.tid & 3, b = (F.tid >> 2) & 1, cg = F.tid >> 3; float s = 0.f;
#pragma unroll
              for (int kp = 0; kp < 21; ++kp) s += red[((kp * 24 + cg) * 2 + b) * 4 + i];
              const int cl = cl0 + 4 * cg + i; s += ((const float*)kargp(I_BADA))[layer * 12288 + cl];
              ((float*)(F.ws + WS_MOD))[(size_t)(layer * 2 + b) * 12288 + cl] = s; }
          __syncthreads();
      } }
    }
    }
}

template <bool FINAL, bool IN_F32>
__device__ __forceinline__ void p_norm(Frame& F, const void* x, const float* w, const float* modl  , int shift_off, int scale_off, signed char* outb, float* hsc, float* outf) {
    const int gw = F.vcu * NWAVES + F.wave, NGW = F.G * NWAVES;
    for (int row = gw; row < NTOK; row += NGW) {
        f32x4 v[8]; float s = 0.f;
        if (IN_F32) { const f32x4* xr = (const f32x4*)((const float*)x + (size_t)row * D) + F.lane;
#pragma unroll
            for (int j = 0; j < 8; ++j) v[j] = xr[64 * j]; }
        else { const u32x2* xr = (const u32x2*)((const bf16_t*)x + (size_t)row * D) + F.lane;
#pragma unroll
            for (int j = 0; j < 8; ++j) { const u32x2 xw = xr[64 * j]; v[j] = (f32x4){bflo(xw.x), bfhi(xw.x), bflo(xw.y), bfhi(xw.y)}; } }
#pragma unroll
        for (int j = 0; j < 8; ++j) s += (v[j][0] * v[j][0] + v[j][1] * v[j][1]) + (v[j][2] * v[j][2] + v[j][3] * v[j][3]);
        const float rstd = 1.0f / sqrtf(wave_sum(s) * (1.0f / D) + EPS);
        if (FINAL) {
#pragma unroll
            for (int j = 0; j < 8; ++j) { const f32x4 wv = *((const f32x4*)w + 64 * j + F.lane); *((f32x4*)(outf + (size_t)row * D) + 64 * j + F.lane) = v[j] * rstd * wv; }
        } else {
            const float* mb = modl + (size_t)(row >> 14) * 12288; float am = 0.f;
#pragma unroll
            for (int j = 0; j < 8; ++j) { const f32x4 wv = *((const f32x4*)w + 64 * j + F.lane), sc = *((const f32x4*)(mb + scale_off) + 64 * j + F.lane), sh = *((const f32x4*)(mb + shift_off) + 64 * j + F.lane);
                v[j] = v[j] * rstd * wv * (sc + 1.0f) + sh;
                am = fmaxf(am, fmaxf(fmaxf(fabsf(v[j][0]), fabsf(v[j][1])), fmaxf(fabsf(v[j][2]), fabsf(v[j][3])))); }
#pragma unroll
            for (int o = 1; o < 64; o <<= 1) am = fmaxf(am, __shfl_xor(am, o));
            am = fmaxf(am, 1e-20f); const float inv = 127.0f / am;
            if (F.lane == 0) hsc[row] = am * (1.0f / 127.0f);
#pragma unroll
            for (int j = 0; j < 8; ++j) { *((unsigned*)(outb + (size_t)row * D) + 64 * j + F.lane) = q4(v[j] * inv); }
        }
    }
}

__device__ __forceinline__ void p_scan(Frame& F) {
    const int gt = F.vcu * NTHR + F.tid;
    if (gt >= 8 * 256 * 32) return;
    const int bh = gt >> 13, rem = gt & 8191, h = bh & 3;
    const float cd = exp2f(log2_gamma(h) * 128.0f);
    u32x2* p = (u32x2*)(F.ws + WS_KVT + (size_t)bh * 128 * 65536 + (size_t)rem * 8);
    f32x4 s0 = {0.f, 0.f, 0.f, 0.f}, s1 = {0.f, 0.f, 0.f, 0.f};
    for (int c0 = 0; c0 < NCH; c0 += 8) {
        u32x2 kv[8];
#pragma unroll
        for (int i = 0; i < 8; ++i) kv[i] = p[(size_t)(c0 + i) * (65536 / 8)];
#pragma unroll
        for (int i = 0; i < 8; ++i) { p[(size_t)(c0 + i) * (65536 / 8)] = f8pack(s0, s1);
            f32x4 k0, k1; f8unpack(kv[i], k0, k1); s0 = s0 * cd + k0; s1 = s1 * cd + k1; }
    }
}

template <bool WIDE> __device__ __forceinline__ void piece_load(u32x4 (&r)[4], const bf16_t* base, size_t gpitch, int tid) {
    const bf16_t* p0 = base + (size_t)(WIDE ? tid >> 5 : tid >> 4) * gpitch + (WIDE ? tid & 31 : tid & 15) * 8;
#pragma unroll
    for (int i = 0; i < 4; ++i) r[i] = *(const u32x4*)(p0 + (size_t)(WIDE ? 16 : 32) * i * gpitch);
}
__device__ __forceinline__ void piece_load8(u32x4 (&r)[4], const unsigned char* base, int tid) {
    const unsigned char* p0 = base + (tid >> 5) * 256 + (tid & 31) * 8;
#pragma unroll
    for (int i = 0; i < 4; ++i) { const u32x2 v = *(const u32x2*)(p0 + 16 * i * 256); r[i].x = v.x; r[i].y = v.y; }
}
__device__ __forceinline__ void piece_cvt8(u32x4 (&r)[4]) {
#pragma unroll
    for (int i = 0; i < 4; ++i) { f32x4 a, b; u32x2 v; v.x = r[i].x; v.y = r[i].y; f8unpack(v, a, b);
        r[i].x = pk2(a[0], a[1]); r[i].y = pk2(a[2], a[3]); r[i].z = pk2(b[0], b[1]); r[i].w = pk2(b[2], b[3]); }
}
__device__ __forceinline__ void piece_store(LAS unsigned char* buf, int st0, const u32x4 (&r)[4]) {
#pragma unroll
    for (int i = 0; i < 4; ++i) *(LAS u32x4*)(buf + st0 + 8192 * i) = r[i];
}
__device__ __forceinline__ void p_retsg(Frame& F, const Args& a, int layer) {
    const bf16_t* Q = (const bf16_t*)(F.ws + WS_Q); const bf16_t* Kk = (const bf16_t*)(F.ws + WS_K); const bf16_t* Gg = (const bf16_t*)(F.ws + WS_G); const bf16_t* Uu = (const bf16_t*)(F.ws + WS_U);
    const bf16_t* VT = (const bf16_t*)(F.ws + WS_VT); const bf16_t* VST = (const bf16_t*)(F.ws + WS_VST); const unsigned char* ST = (const unsigned char*)(F.ws + WS_KVT);
    bf16_t* MIX = (bf16_t*)(F.ws + WS_HBUF);
    const float* rnw = (const float*)kargp(I_RNW) + (size_t)layer * RW;
    const int tid = F.tid; const int l16 = tid & 15, g = (tid >> 4) & 3, w = __builtin_amdgcn_readfirstlane(tid >> 6);
    LAS unsigned char* buf0 = F.lds; LAS unsigned char* buf1 = F.lds + 32768;
    int swW[8];
    const int ldsb = (int)(unsigned)(size_t)F.lds;
#pragma unroll
    for (int s = 0; s < 8; ++s) { swW[s] = ldsb + ((l16 * 32 + ((4 * s + g) ^ l16)) << 4); asm volatile("" : "+v"(swW[s])); }
#define LRD128(dst, addr, off) asm volatile("ds_read_b128 %0, %1 offset:%2" : "=v"(dst) : "v"(addr), "n"(off) : "memory")
#define LWAIT4(q) asm volatile("s_waitcnt lgkmcnt(0)" : "+v"((q)[0]), "+v"((q)[1]), "+v"((q)[2]), "+v"((q)[3]) :: "memory")
#define BO(p) (((p) % 3) * 32768)
#define AW(s, p) (((p) % 3) == 2 ? swW[(s)] + 65536 : swW[(s)])
#define OFFB(p) (((p) % 3) == 2 ? 0 : ((p) % 3) * 32768)
#define RD4_W(q, pp, rt, s0) do { LRD128((q)[0], AW((s0), pp), OFFB(pp) + (rt) * 8192); LRD128((q)[1], AW((s0) + 1, pp), OFFB(pp) + (rt) * 8192); LRD128((q)[2], AW((s0) + 2, pp), OFFB(pp) + (rt) * 8192); LRD128((q)[3], AW((s0) + 3, pp), OFFB(pp) + (rt) * 8192); } while (0)
#define WAITV(n) asm volatile("s_waitcnt vmcnt(" #n ")" ::: "memory")
#define LBAR() asm volatile("s_waitcnt lgkmcnt(0)\n\ts_barrier" ::: "memory")
    const unsigned ldsw = (unsigned)__builtin_amdgcn_readfirstlane(w) * 1024u;
#define DV_S ((unsigned)(tid >> 4) * 256u + (unsigned)(tid & 15) * 16u)
#define DV_W ((unsigned)(tid >> 5) * 2048u + (unsigned)((tid & 31) ^ ((tid >> 5) & 15)) * 16u)
#define DV_N ((unsigned)(tid >> 4) * 256u + (unsigned)((tid & 15) ^ ((tid >> 4) & 15)) * 16u)
#define CV_S ((((((tid >> 4) & 15) * 32) + ((2 * (tid & 15)) ^ ((tid >> 4) & 15))) << 4) + (tid >> 8) * 8192)
#define RET_DMA_STATE(sbase, qq) do { const char* gb_ = (const char*)(sbase) + (size_t)(64 * (qq)) * 256; unsigned o_ = DV_S; asm volatile("" : "+v"(o_));   _Pragma("unroll") for (int j_ = 0; j_ < 2; ++j_) \
        __builtin_amdgcn_global_load_lds((const unsigned*)(gb_ + (o_ + 8192u * (unsigned)j_)), (LAS unsigned*)(F.lds + 98304 + ((qq) & 1) * 16384 + j_ * 8192 + ldsw), 16, 0, 0); } while (0)
#define RET_DMA_WIDE(kbase, kq, pp) do { const char* gb_ = (const char*)((kbase) + (size_t)(64 * (kq)) * 1024); unsigned o_ = DV_W; asm volatile("" : "+v"(o_)); _Pragma("unroll") for (int i_ = 0; i_ < 4; ++i_) \
        __builtin_amdgcn_global_load_lds((const unsigned*)(gb_ + (o_ + 32768u * (unsigned)i_)), (LAS unsigned*)(F.lds + BO(pp) + i_ * 8192 + ldsw), 16, 0, 0); } while (0)
#define RET_DMA_NARROW(vbase, vq, pp) do { const char* gb_ = (const char*)((vbase) + (size_t)(128 * (vq)) * 128); unsigned o_ = DV_N; asm volatile("" : "+v"(o_)); _Pragma("unroll") for (int i_ = 0; i_ < 4; ++i_) \
        __builtin_amdgcn_global_load_lds((const unsigned*)(gb_ + (o_ + 8192u * (unsigned)i_)), (LAS unsigned*)(F.lds + BO(pp) + i_ * 8192 + ldsw), 16, 0, 0); } while (0)
#define RD4_N(q, bo, rt) do { LRD128((q)[0], swN[0], (bo) + (rt) * 4096); LRD128((q)[1], swN[1], (bo) + (rt) * 4096); LRD128((q)[2], swN[2], (bo) + (rt) * 4096); LRD128((q)[3], swN[3], (bo) + (rt) * 4096); } while (0)
    LAS float* rr = (LAS float*)(F.lds + 65536);
    if (F.vcu < 256) { const int U = F.vcu;
    float rowam = 0.f;
    bf16x8 qf[8];
    {   const bf16_t* qrow = Q + (size_t)((U >> 7) * SEQ + (U & 127) * CH + 16 * w + l16) * 1024 + 8 * g;
#pragma unroll
        for (int s = 0; s < 8; ++s) qf[s] = *(const bf16x8*)(qrow + 32 * s); }
    for (int h = 0; h < RH; ++h) {
        const int ch = U & 127, b = U >> 7, L = b * 512 + h * 128 + ch;
        const int T0 = b * SEQ + ch * CH;
        const float lg = log2_gamma(h);
        const int nloc = 16 * w + l16;
        u32x2 gwp[16];
        f32x4 acc[16];
#pragma unroll
        for (int et = 0; et < 16; ++et) acc[et] = (f32x4){0.f, 0.f, 0.f, 0.f};
        unsigned pt[8][2];
        const unsigned char* stb = ST + (size_t)L * 65536; const bf16_t* kb = Kk + (size_t)T0 * 1024 + h * 256; const bf16_t* vb = VT + ((size_t)(T0 >> 7) * 1024 + (size_t)(h * 256)) * 128;
        const unsigned char* stbn = stb + (size_t)128 * 65536;
        if (h == 0) { RET_DMA_STATE(stb, 0); RET_DMA_STATE(stb, 1); }
        LBAR();
#pragma unroll
        for (int p = 0; p < 8; ++p) {
            LAS unsigned char* buf = F.lds + BO(p);
            if (p == 0) { if (h == 0) WAITV(2); else WAITV(16); } else if (p < 3) WAITV(2); else if (p < 7) WAITV(4); else { if (h + 1 < RH) WAITV(26); else WAITV(16); }
            if (p < 4) {
                const LAS unsigned char* rawp = F.lds + 98304 + (p & 1) * 16384 + tid * 16;
                int cvS = CV_S; asm volatile("" : "+v"(cvS));
                LAS unsigned char* db = F.lds + BO(p) + cvS;
#pragma unroll
                for (int j = 0; j < 2; ++j) { const u32x4 rv = *(const LAS u32x4*)(rawp + j * 8192);
                    f32x4 a, b2; u32x2 v; u32x4 o;
                    v.x = rv.x; v.y = rv.y; f8unpack(v, a, b2); o.x = pk2(a[0], a[1]); o.y = pk2(a[2], a[3]); o.z = pk2(b2[0], b2[1]); o.w = pk2(b2[2], b2[3]);
                    *(LAS u32x4*)(db + j * 16384) = o;
                    v.x = rv.z; v.y = rv.w; f8unpack(v, a, b2); o.x = pk2(a[0], a[1]); o.y = pk2(a[2], a[3]); o.z = pk2(b2[0], b2[1]); o.w = pk2(b2[2], b2[3]);
                    *(LAS u32x4*)(F.lds + BO(p) + (cvS ^ 16) + j * 16384) = o; }
            }
            LBAR();
            if (p + 2 < 4) RET_DMA_STATE(stb, p + 2);
            else if (p + 2 < 6) RET_DMA_WIDE(kb, p + 2 - 4, p + 2);
            else if (p + 2 < 8) RET_DMA_NARROW(vb, p + 2 - 6, p + 2);
            else if (h + 1 < RH) RET_DMA_STATE(stbn, p + 2 - 8);
            if (p == 6) {
                if (h + 1 < RH) { const bf16_t* qrow = Q + (size_t)(T0 + nloc) * 1024 + (h + 1) * 256 + 8 * g;
#pragma unroll
                    for (int s = 0; s < 8; ++s) qf[s] = *(const bf16x8*)(qrow + 32 * s); }
#pragma unroll
                for (int et = 0; et < 16; ++et) gwp[et] = *(const u32x2*)(Gg + (size_t)(T0 + nloc) * 1024 + h * 256 + 16 * et + 4 * g);
            }
            if (p < 4) {
                {   bf16x8 fq[2][4];
                    RD4_W(fq[0], p, 0, 0);
#pragma unroll
                    for (int k = 0; k < 8; ++k) {
                        LWAIT4(fq[k & 1]);
                        if (k + 1 < 8) RD4_W(fq[(k + 1) & 1], p, (k + 1) >> 1, 4 * ((k + 1) & 1));
#pragma unroll
                        for (int j = 0; j < 4; ++j) acc[4 * p + (k >> 1)] = __builtin_amdgcn_mfma_f32_16x16x32_bf16(fq[k & 1][j], qf[4 * (k & 1) + j], acc[4 * p + (k >> 1)], 0, 0, 0);
                    } }
                if (p == 3) { const float qd = __builtin_amdgcn_exp2f(lg * (float)(nloc + 1));
#pragma unroll
                    for (int et = 0; et < 16; ++et) acc[et] *= qd; }
            } else if (p < 6) {
                if (p == 4) {
#pragma unroll
                    for (int t = 0; t < 8; ++t) { pt[t][0] = 0u; pt[t][1] = 0u; } }
#pragma unroll
                for (int ml = 0; ml < 4; ++ml) { const int t = 4 * (p - 4) + ml;
                    if (t <= w) { f32x4 sc = {0.f, 0.f, 0.f, 0.f};
                        bf16x8 fa[2][2];
                        LRD128(fa[0][0], AW(0, p), OFFB(p) + ml * 8192); LRD128(fa[0][1], AW(1, p), OFFB(p) + ml * 8192);
#pragma unroll
                        for (int k = 0; k < 4; ++k) {
                            asm volatile("s_waitcnt lgkmcnt(0)" : "+v"(fa[k & 1][0]), "+v"(fa[k & 1][1]) :: "memory");
                            if (k + 1 < 4) { LRD128(fa[(k + 1) & 1][0], AW(2 * (k + 1), p), OFFB(p) + ml * 8192); LRD128(fa[(k + 1) & 1][1], AW(2 * (k + 1) + 1, p), OFFB(p) + ml * 8192); }
                            sc = __builtin_amdgcn_mfma_f32_16x16x32_bf16(fa[k & 1][0], qf[2 * k], sc, 0, 0, 0);
                            sc = __builtin_amdgcn_mfma_f32_16x16x32_bf16(fa[k & 1][1], qf[2 * k + 1], sc, 0, 0, 0);
                        }
                        float pv[4];
#pragma unroll
                        for (int r = 0; r < 4; ++r) { const int df = nloc - (16 * t + 4 * g + r); pv[r] = df >= 0 ? sc[r] * __builtin_amdgcn_exp2f(lg * (float)df) : 0.f; }
                        pt[t][0] = pk2(pv[0], pv[1]); pt[t][1] = pk2(pv[2], pv[3]); }
                    asm volatile("" ::: "memory"); }
            } else {
#pragma unroll
                for (int u = 0; u < 4; ++u) {
                    if (2 * u <= w) { u32x4 bw; bw.x = pt[2 * u][0]; bw.y = pt[2 * u][1]; bw.z = pt[2 * u + 1][0]; bw.w = pt[2 * u + 1][1];
                        const bf16x8 bf = __builtin_bit_cast(bf16x8, bw);
                        const int sP0 = ((l16 * 16 + ((4 * u + (g >> 1)) ^ l16)) << 4) + 8 * (g & 1), sP1 = ((l16 * 16 + ((4 * u + 2 + (g >> 1)) ^ l16)) << 4) + 8 * (g & 1);
#pragma unroll
                        for (int el = 0; el < 8; ++el) { const u32x2 lo = *(const LAS u32x2*)(buf + sP0 + el * 4096), hi = *(const LAS u32x2*)(buf + sP1 + el * 4096);
                            u32x4 aw; aw.x = lo.x; aw.y = lo.y; aw.z = hi.x; aw.w = hi.y;
                            acc[8 * (p - 6) + el] = __builtin_amdgcn_mfma_f32_16x16x32_bf16(__builtin_bit_cast(bf16x8, aw), bf, acc[8 * (p - 6) + el], 0, 0, 0); }
                        asm volatile("" ::: "memory"); } }
            }
        }
        float ss = 0.f;
#pragma unroll
        for (int et = 0; et < 16; ++et) ss += (acc[et][0] * acc[et][0] + acc[et][1] * acc[et][1]) + (acc[et][2] * acc[et][2] + acc[et][3] * acc[et][3]);
        ss += __shfl_xor(ss, 16); ss += __shfl_xor(ss, 32);
        const float rstd = 1.0f / sqrtf(ss * (1.0f / RD) + EPS);
        const size_t tokoff = (size_t)(T0 + nloc);
        float am = 0.f;
#pragma unroll
        for (int et = 0; et < 16; ++et) { const int e = h * 256 + 16 * et + 4 * g;
            const f32x4 wv = *(const f32x4*)(rnw + e); const u32x2 gw = gwp[et];
            const float o0 = acc[et][0] * rstd * wv[0] * bflo(gw.x), o1 = acc[et][1] * rstd * wv[1] * bfhi(gw.x), o2 = acc[et][2] * rstd * wv[2] * bflo(gw.y), o3 = acc[et][3] * rstd * wv[3] * bfhi(gw.y);
            am = fmaxf(am, fmaxf(fmaxf(fabsf(o0), fabsf(o1)), fmaxf(fabsf(o2), fabsf(o3))));
            u32x2 ow; ow.x = pk2(o0, o1); ow.y = pk2(o2, o3);
            *(u32x2*)(MIX + tokoff * D + e) = ow; }
        am = fmaxf(am, __shfl_xor(am, 16)); am = fmaxf(am, __shfl_xor(am, 32)); rowam = fmaxf(rowam, am);
    }
    {
        const int L = U;
        const int ch = L & 127, b = L >> 7; const int T0 = b * SEQ + ch * CH;
        const bf16_t* swb = (const bf16_t*)(F.ws + WS_SGW) + (size_t)layer * SGG * CH * CH;
        const float* sgb = (const float*)kargp(I_SGB) + (size_t)layer * SGG * CH;
        const bf16_t* vsb = VST + (size_t)(T0 >> 7) * 1024 * 128;
        u32x4 rg[4];
        int tidS = tid; asm volatile("" : "+v"(tidS));
        piece_load<false>(rg, vsb, 128, tidS);
        int gS = g; asm volatile("" : "+v"(gS));
        int swN[4]; const int l16S = tidS & 15;
#pragma unroll
        for (int s = 0; s < 4; ++s) { swN[s] = ldsb + ((l16S * 16 + ((4 * s + gS) ^ l16S)) << 4); asm volatile("" : "+v"(swN[s])); }
        int stN = ((((tidS >> 4) * 16) + ((tidS & 15) ^ ((tidS >> 4) & 15))) << 4); asm volatile("" : "+v"(stN));
        int nloc = 16 * w + l16; asm volatile("" : "+v"(nloc));
        const size_t tokoff = (size_t)(T0 + nloc);
#define SG_LOAD(gq) do { _Pragma("unroll") for (int s = 0; s < 4; ++s) wn[s] = *(const u32x4*)(swb + ((size_t)(gq) * CH + nloc) * CH + 32 * s + 8 * gS);     \
        _Pragma("unroll") for (int dt = 0; dt < 8; ++dt) un[dt] = *(const u32x2*)(Uu + tokoff * 1024 + (gq) * 128 + 16 * dt + 4 * gS); bn = sgb[(gq) * CH + nloc]; } while (0)
        u32x4 wn[4]; u32x2 un[8]; float bn;
        SG_LOAD(0);
        float lam = 0.f;
        __syncthreads();
#pragma unroll
        for (int gi = 0; gi < SGG; ++gi) {
            LAS unsigned char* buf = (gi & 1) ? buf1 : buf0;
            piece_store(buf, stN, rg);
            u32x4 wcur[4]; u32x2 ucur[8];
#pragma unroll
            for (int s = 0; s < 4; ++s) wcur[s] = wn[s];
#pragma unroll
            for (int dt = 0; dt < 8; ++dt) ucur[dt] = un[dt];
            const float bias = bn;
            __syncthreads();
            if (gi + 1 < SGG) { piece_load<false>(rg, vsb + (size_t)((gi + 1) * 128) * 128, 128, tidS); SG_LOAD(gi + 1); }
            {
                const int tk = tid & 127, qt = tid >> 7; float sq = 0.f;
#pragma unroll 8
                for (int d = 32 * qt; d < 32 * qt + 32; ++d) { const bf16_t v = *(const LAS bf16_t*)(buf + ((d * 16 + ((tk >> 3) ^ (d & 15))) << 4) + 2 * (tk & 7)); const float f = __builtin_bit_cast(float, ((unsigned)v) << 16); sq += f * f; }
                rr[512 + qt * 128 + tk] = sq;
            }
            __syncthreads();
            if (tid < 128) rr[tid] = 1.0f / sqrtf((rr[512 + tid] + rr[640 + tid] + rr[768 + tid] + rr[896 + tid]) * (1.0f / SGD) + EPS);
            __syncthreads();
            bf16x8 bfr[4];
#pragma unroll
            for (int s = 0; s < 4; ++s) {
                u32x4 ww;
                {
                    const u32x4 wv = wcur[s];
                    const f32x4 r0 = *(const LAS f32x4*)(rr + 32 * s + 8 * g), r1 = *(const LAS f32x4*)(rr + 32 * s + 8 * g + 4);
                    ww.x = pk2(bflo(wv.x) * r0[0], bfhi(wv.x) * r0[1]); ww.y = pk2(bflo(wv.y) * r0[2], bfhi(wv.y) * r0[3]);
                    ww.z = pk2(bflo(wv.z) * r1[0], bfhi(wv.z) * r1[1]); ww.w = pk2(bflo(wv.w) * r1[2], bfhi(wv.w) * r1[3]);
                }
                bfr[s] = __builtin_bit_cast(bf16x8, ww);
            }
            bf16x8 fz[2][4];
            if (gi & 1) RD4_N(fz[0], 32768, 0); else RD4_N(fz[0], 0, 0);
#pragma unroll
            for (int dt = 0; dt < 8; ++dt) {
                f32x4 z = {0.f, 0.f, 0.f, 0.f};
                LWAIT4(fz[dt & 1]);
                if (dt + 1 < 8) { if (gi & 1) RD4_N(fz[(dt + 1) & 1], 32768, dt + 1); else RD4_N(fz[(dt + 1) & 1], 0, dt + 1); }
#pragma unroll
                for (int s = 0; s < 4; ++s) z = __builtin_amdgcn_mfma_f32_16x16x32_bf16(fz[dt & 1][s], bfr[s], z, 0, 0, 0);
                const int d = gi * 128 + 16 * dt + 4 * gS;
                const u32x2 uw = ucur[dt];
                const float o0 = bflo(uw.x) * (z[0] + bias), o1 = bfhi(uw.x) * (z[1] + bias), o2 = bflo(uw.y) * (z[2] + bias), o3 = bfhi(uw.y) * (z[3] + bias);
                lam = fmaxf(lam, fmaxf(fmaxf(fabsf(o0), fabsf(o1)), fmaxf(fabsf(o2), fabsf(o3))));
                u32x2 ow; ow.x = pk2(o0, o1); ow.y = pk2(o2, o3);
                *(u32x2*)(MIX + tokoff * D + 1024 + d) = ow;
            }
        }
#undef SG_LOAD
        lam = fmaxf(lam, __shfl_xor(lam, 16)); lam = fmaxf(lam, __shfl_xor(lam, 32)); rowam = fmaxf(rowam, lam);
        asm volatile("s_waitcnt vmcnt(0)" ::: "memory");
        signed char* MIXQ = (signed char*)(F.ws + WS_MIXQ); float* msc = (float*)(F.ws + WS_HSC);
#define QLOAD(dst, tq) do { _Pragma("unroll") for (int tt = 0; tt < 2; ++tt) { const int tok_ = T0 + 16 * w + 2 * (tq) + tt; \
            _Pragma("unroll") for (int i = 0; i < 4; ++i) dst[tt][i] = *((const u32x4*)(MIX + (size_t)tok_ * D) + 64 * i + F.lane); } } while (0)
        u32x4 rv[2][4];
        QLOAD(rv, 0);
#pragma unroll
        for (int t2 = 0; t2 < 8; ++t2) {
            u32x4 rn[2][4]; float inv[2];
            if (t2 + 1 < 8) QLOAD(rn, t2 + 1);
#pragma unroll
            for (int tt = 0; tt < 2; ++tt) { const float a_ = fmaxf(__shfl(rowam, 2 * t2 + tt), 1e-20f); inv[tt] = 127.0f / a_;
                if (F.lane == 0) msc[T0 + 16 * w + 2 * t2 + tt] = a_ * (1.0f / 127.0f); }
#pragma unroll
            for (int tt = 0; tt < 2; ++tt) { const int tok = T0 + 16 * w + 2 * t2 + tt;
#pragma unroll
                for (int i = 0; i < 4; ++i) { const u32x4 v = rv[tt][i]; u32x2 q;
                    q.x = q4((f32x4){bflo(v.x), bfhi(v.x), bflo(v.y), bfhi(v.y)} * inv[tt]); q.y = q4((f32x4){bflo(v.z), bfhi(v.z), bflo(v.w), bfhi(v.w)} * inv[tt]);
                    *((u32x2*)(MIXQ + (size_t)tok * D) + 64 * i + F.lane) = q; } }
#pragma unroll
            for (int tt = 0; tt < 2; ++tt)
#pragma unroll
                for (int i = 0; i < 4; ++i) rv[tt][i] = rn[tt][i];
        }
#undef QLOAD
    }
    }
    __syncthreads();
#undef DV_S
#undef DV_W
#undef DV_N
#undef CV_S
#undef BO
#undef AW
#undef OFFB
#undef WAITV
#undef LBAR
#undef RET_DMA_STATE
#undef RET_DMA_WIDE
#undef RET_DMA_NARROW
#undef LRD128
#undef LWAIT4
#undef RD4_W
#undef RD4_N
}

__device__ __forceinline__ void p_rbias(Frame& F, int layer) {
    if (F.vcu >= NB) return;
    const int b = F.vcu; LAS float* rbp = (LAS float*)(F.lds + 12288);
    const float* mb = (const float*)(F.ws + WS_MOD) + (size_t)(layer * 2 + b) * 12288 + 6144; const float* wr = (const float*)kargp(I_WR);
    const int e = F.tid & 31, part = F.tid >> 5; float s0 = 0.f, s1 = 0.f, s2 = 0.f, s3 = 0.f;
#pragma unroll 4
    for (int k = part * 128; k < part * 128 + 128; k += 4) { s0 += mb[k] * wr[k * NE + e]; s1 += mb[k + 1] * wr[(k + 1) * NE + e]; s2 += mb[k + 2] * wr[(k + 2) * NE + e]; s3 += mb[k + 3] * wr[(k + 3) * NE + e]; }
    rbp[part * 32 + e] = (s0 + s1) + (s2 + s3);
    __syncthreads();
    if (F.tid < 32) { float s = 0.f;
#pragma unroll
        for (int q = 0; q < 16; ++q) s += rbp[q * 32 + F.tid];
        ((float*)(F.ws + WS_RBW))[(layer * 2 + b) * 32 + F.tid] = s; }
}
__device__ __forceinline__ void p_router(Frame& F, const Args& a, int layer, const bf16_t* x1) {
    LAS float* cs = (LAS float*)F.lds;
    LAS float* sh = cs + 2048;
    LAS float* plog = sh + 2048;
    LAS float* red = plog + 4096;
    LAS float* rstdl = red + 128;
    LAS float* rb = rstdl + 16;
    LAS float* scl = rb + 32;
    LAS float* bsl = scl + 512;
    LAS unsigned* cnt = (LAS unsigned*)(bsl + 512);
    LAS unsigned* basel = cnt + 48;
    LAS int* tokb = (LAS int*)(basel + 48);
    LAS int* tokr = tokb + 128;
    LAS float* amaxl = (LAS float*)(tokr + 128);
    LAS float* gll = amaxl + 128;
    LAS float* scll = gll + 256;
    const float* modl = (const float*)(F.ws + WS_MOD) + (size_t)layer * 2 * 12288;
    const float* n2w = (const float*)kargp(I_N2W) + (size_t)layer * D;
    const float* rbias = (const float*)kargp(I_RB);
    const bf16_t* wrt = (const bf16_t*)(F.ws + WS_WRT);
    signed char* H2 = (signed char*)(F.ws + WS_HBUF); float* hsc = (float*)(F.ws + WS_HSC);
    unsigned* gcnt = (unsigned*)(F.ws + WS_CTL) + CW_CNT + layer * 64;
    const int l16 = F.lane & 15, g = F.lane >> 4, w = F.wave;
    bf16x8 bfr[8][2];
#pragma unroll
    for (int s = 0; s < 8; ++s)
#pragma unroll
        for (int et = 0; et < 2; ++et) bfr[s][et] = *(const bf16x8*)(wrt + (size_t)(16 * et + l16) * D + 256 * w + 32 * s + 8 * g);
    for (int wgp = F.vcu; wgp < NTOK / 128; wgp += F.G) {
        const int tok0 = wgp * 128, b = tok0 >> 14; const float* mb = modl + (size_t)b * 12288;
        const bf16_t* xbase = x1 + (size_t)(tok0 + l16) * D + 256 * w + 8 * g;
        u32x4 xnext[8];
#pragma unroll
        for (int s = 0; s < 8; ++s) xnext[s] = *(const u32x4*)(xbase + 32 * s);
        __syncthreads();
        for (int i = F.tid; i < D; i += NTHR) { cs[i] = n2w[i] * (1.0f + mb[8192 + i]); sh[i] = mb[6144 + i]; }
        if (F.tid < 48) cnt[F.tid] = 0u;
        if (F.tid < 32) rb[F.tid] = ((const float*)(F.ws + WS_RBW))[(layer * 2 + b) * 32 + F.tid];
        __syncthreads();
        for (int ti = 0; ti < 8; ++ti) {
            const int r0 = tok0 + 16 * ti;
            f32x4 xv[8][2];
#pragma unroll
            for (int s = 0; s < 8; ++s) { xv[s][0] = (f32x4){bflo(xnext[s].x), bfhi(xnext[s].x), bflo(xnext[s].y), bfhi(xnext[s].y)}; xv[s][1] = (f32x4){bflo(xnext[s].z), bfhi(xnext[s].z), bflo(xnext[s].w), bfhi(xnext[s].w)}; }
            if (ti + 1 < 8) {
#pragma unroll
                for (int s = 0; s < 8; ++s) xnext[s] = *(const u32x4*)(xbase + (size_t)(16 * (ti + 1)) * D + 32 * s); }
            float ssq = 0.f; f32x4 lacc[2] = {{0.f, 0.f, 0.f, 0.f}, {0.f, 0.f, 0.f, 0.f}};
#pragma unroll
            for (int s = 0; s < 8; ++s) {
                const f32x4 c0 = *(const LAS f32x4*)(cs + 256 * w + 32 * s + 8 * g), c1 = *(const LAS f32x4*)(cs + 256 * w + 32 * s + 8 * g + 4);
                const f32x4 a0 = xv[s][0], a1 = xv[s][1];
                ssq += (a0[0] * a0[0] + a0[1] * a0[1]) + (a0[2] * a0[2] + a0[3] * a0[3]) + (a1[0] * a1[0] + a1[1] * a1[1]) + (a1[2] * a1[2] + a1[3] * a1[3]);
                const f32x4 y0 = a0 * c0, y1 = a1 * c1;
                u32x4 aw; aw.x = pk2(y0[0], y0[1]); aw.y = pk2(y0[2], y0[3]); aw.z = pk2(y1[0], y1[1]); aw.w = pk2(y1[2], y1[3]);
                const bf16x8 af = __builtin_bit_cast(bf16x8, aw);
                lacc[0] = __builtin_amdgcn_mfma_f32_16x16x32_bf16(af, bfr[s][0], lacc[0], 0, 0, 0);
                lacc[1] = __builtin_amdgcn_mfma_f32_16x16x32_bf16(af, bfr[s][1], lacc[1], 0, 0, 0);
            }
            ssq += __shfl_xor(ssq, 16); ssq += __shfl_xor(ssq, 32);
            if (g == 0) red[w * 16 + l16] = ssq;
#pragma unroll
            for (int et = 0; et < 2; ++et)
#pragma unroll
                for (int r = 0; r < 4; ++r) plog[(w * 16 + 4 * g + r) * 32 + 16 * et + l16] = lacc[et][r];
            __syncthreads();
            { const int row = F.tid >> 5, e = F.tid & 31; float raw = 0.f, ss = 0.f;
#pragma unroll
              for (int ww = 0; ww < 8; ++ww) { raw += plog[(ww * 16 + row) * 32 + e]; ss += red[ww * 16 + row]; }
              const float rstd = 1.0f / sqrtf(ss * (1.0f / D) + EPS);
              const float sc = sigmoidf_(rstd * raw + rb[e]);
              scl[row * 32 + e] = sc; bsl[row * 32 + e] = sc + rbias[e];
              if (e == 0) rstdl[row] = rstd; }
            __syncthreads();
            if (F.tid < 128) {
                const int row = F.tid >> 3, gq = F.tid & 7;
                const f32x4 bs = *(const LAS f32x4*)(bsl + row * 32 + gq * 4), sc = *(const LAS f32x4*)(scl + row * 32 + gq * 4);
                int i1 = 0; float m1 = bs[0];
                if (bs[1] > m1) { m1 = bs[1]; i1 = 1; } if (bs[2] > m1) { m1 = bs[2]; i1 = 2; } if (bs[3] > m1) { m1 = bs[3]; i1 = 3; }
                int i2 = -1; float m2 = -1e30f;
                if (i1 != 0 && bs[0] > m2) { m2 = bs[0]; i2 = 0; } if (i1 != 1 && bs[1] > m2) { m2 = bs[1]; i2 = 1; } if (i1 != 2 && bs[2] > m2) { m2 = bs[2]; i2 = 2; } if (i1 != 3 && bs[3] > m2) { m2 = bs[3]; i2 = 3; }
                float val = m1 + m2; int idx = gq;
#pragma unroll
                for (int off = 1; off < 8; off <<= 1) { const float ov = __shfl_xor(val, off); const int oi = __shfl_xor(idx, off); if (ov > val || (ov == val && oi < idx)) { val = ov; idx = oi; } }
                if (gq == idx) {
                    const float s1 = i1 == 0 ? sc[0] : i1 == 1 ? sc[1] : i1 == 2 ? sc[2] : sc[3], s2 = i2 == 0 ? sc[0] : i2 == 1 ? sc[1] : i2 == 2 ? sc[2] : sc[3];
                    const float inv = 1.0f / (s1 + s2);
                    const int lo = i1 < i2 ? i1 : i2, hi = i1 < i2 ? i2 : i1;
                    const float glo = (i1 < i2 ? s1 : s2) * inv, ghi = (i1 < i2 ? s2 : s1) * inv;
                    const int pp = lo == 0 ? hi - 1 : lo == 1 ? hi + 1 : 5;
                    const int bucket = gq * 6 + pp;
                    const int lt = ti * 16 + row;
                    tokb[lt] = bucket; tokr[lt] = (int)__hip_atomic_fetch_add(&cnt[bucket], 1u, __ATOMIC_RELAXED, __HIP_MEMORY_SCOPE_WORKGROUP);
                    gll[lt * 2] = glo; gll[lt * 2 + 1] = ghi;
                }
            }
            {
                const float rstd = rstdl[l16]; float am = 0.f;
#pragma unroll
                for (int s = 0; s < 8; ++s) {
                    const f32x4 c0 = *(const LAS f32x4*)(cs + 256 * w + 32 * s + 8 * g), c1 = *(const LAS f32x4*)(cs + 256 * w + 32 * s + 8 * g + 4);
                    const f32x4 h0 = *(const LAS f32x4*)(sh + 256 * w + 32 * s + 8 * g), h1 = *(const LAS f32x4*)(sh + 256 * w + 32 * s + 8 * g + 4);
                    xv[s][0] = xv[s][0] * rstd * c0 + h0; xv[s][1] = xv[s][1] * rstd * c1 + h1;
                    am = fmaxf(am, fmaxf(fmaxf(fmaxf(fabsf(xv[s][0][0]), fabsf(xv[s][0][1])), fmaxf(fabsf(xv[s][0][2]), fabsf(xv[s][0][3]))), fmaxf(fmaxf(fabsf(xv[s][1][0]), fabsf(xv[s][1][1])), fmaxf(fabsf(xv[s][1][2]), fabsf(xv[s][1][3]))))); }
                am = fmaxf(am, __shfl_xor(am, 16)); am = fmaxf(am, __shfl_xor(am, 32));
                if (g == 0) amaxl[w * 16 + l16] = am;
                __syncthreads();
                float ra = 1e-20f;
#pragma unroll
                for (int ww = 0; ww < 8; ++ww) ra = fmaxf(ra, amaxl[ww * 16 + l16]);
                const float inv = 127.0f / ra;
                if (w == 0 && g == 0) { hsc[r0 + l16] = ra * (1.0f / 127.0f); scll[ti * 16 + l16] = ra * (1.0f / 127.0f); }
                signed char* orow = H2 + (size_t)(r0 + l16) * D + 256 * w + 8 * g;
#pragma unroll
                for (int s = 0; s < 8; ++s) { u32x2 ow; ow.x = q4(xv[s][0] * inv); ow.y = q4(xv[s][1] * inv); *(u32x2*)(orow + 32 * s) = ow; }
            }
        }
        __syncthreads();
        if (F.tid < 48) basel[F.tid] = __hip_atomic_fetch_add(gcnt + F.tid, cnt[F.tid], __ATOMIC_RELAXED, __HIP_MEMORY_SCOPE_AGENT);
        __syncthreads();
        if (F.tid < 128) {
            const int bk = tokb[F.tid]; const unsigned bi = ((unsigned)bk << 15) + basel[bk] + (unsigned)tokr[F.tid];
            ((int*)(F.ws + WS_R2TB))[bi] = tok0 + F.tid;
            f32x2 gg; gg.x = gll[F.tid * 2]; gg.y = gll[F.tid * 2 + 1]; ((f32x2*)(F.ws + WS_RGB))[bi] = gg;
            ((float*)(F.ws + WS_RSB))[bi] = scll[F.tid]; }
    }
    __syncthreads();
}

__device__ __forceinline__ void build_tile_table(Frame& F, int layer) {
    LAS int* tt = (LAS int*)(F.lds + TT_OFF);
    const unsigned* gcnt = (const unsigned*)(F.ws + WS_CTL) + CW_CNT + layer * 64;
    __syncthreads();
    if (F.tid == 0) { int t = 0;
        for (int b = 0; b < NBUCK; ++b) { const int c = (int)__hip_atomic_load(gcnt + b, __ATOMIC_RELAXED, __HIP_MEMORY_SCOPE_AGENT); const int n = (c + 255) >> 8; tt[1 + b] = t * 256; tt[320 + b] = c;
            for (int i = 0; i < n; ++i) tt[64 + t + i] = b;
            t += n; }
        tt[0] = t; }
    __syncthreads();
}
__device__ __forceinline__ void p_permute(Frame& F, int layer) {
    build_tile_table(F, layer);
    const LAS int* tt = (const LAS int*)(F.lds + TT_OFF);
    int* r2t = (int*)(F.ws + WS_ROW2TOK); float* rg = (float*)(F.ws + WS_ROWGATE); const float* hsc = (const float*)(F.ws + WS_HSC); float* rsc = (float*)(F.ws + WS_ROWSC);
    const int tok = F.vcu * NTHR + F.tid;
    if (tok < NTOK) {
        const u32x4 rec = *((const u32x4*)(F.ws + WS_TOKINFO) + tok);
        const int row = tt[1 + (int)rec.x] + (int)rec.y;
        r2t[row] = tok; rg[(size_t)row * 2] = u2f(rec.z); rg[(size_t)row * 2 + 1] = u2f(rec.w); rsc[row] = hsc[tok];
    }
}

constexpr int N_PHASES = 22;
__global__ void __launch_bounds__(NTHR, 2) fwd_kernel(Args args) {
    extern __shared__ __attribute__((aligned(16))) unsigned char lds_raw[];
    Frame F;
    F.lds = (LAS unsigned char*)lds_raw;
#define TID() ((int)threadIdx.x)
    F.tid = TID(); F.lane = F.tid & 63; F.wave = __builtin_amdgcn_readfirstlane(F.tid >> 6);
    F.G = gridDim.x; F.vcu = vcu_of(blockIdx.x, F.G); F.ws = (unsigned char*)kargp(19);
    if (F.tid < 16) ((LAS unsigned*)(F.lds + LDSCTL_OFF))[F.tid] = 0u;
    __syncthreads();
    const int lo = args.ph_lo, hi = args.ph_hi;
    const bool one_launch = (hi - lo) > 1;
    XcdBarrier bar; bar.bar = (unsigned*)(F.ws + WS_CTL) + CW_BAR; bar.x = 0; bar.st = (volatile LAS unsigned*)(F.lds + LDSCTL_OFF);
    if (one_launch) bar = xcd_barrier_post((unsigned*)(F.ws + WS_CTL) + CW_BAR, (volatile LAS unsigned*)(F.lds + LDSCTL_OFF));
#define LAUNDER() do { GAS unsigned char* w_ = (GAS unsigned char*)kargp(19); asm volatile("" : "+s"(w_)); F.ws = (unsigned char*)w_;     int t_ = TID(); asm volatile("" : "+v"(t_)); F.tid = t_; F.lane = t_ & 63; F.wave = __builtin_amdgcn_readfirstlane(t_ >> 6); } while (0)
#define IN(k) (lo <= (k) && (k) < hi)
#if MK_STAMP
#define SEAM(k) do { if (IN(k) && IN((k) + 1)) xcd_barrier(bar, TID() == 0); if (blockIdx.x == 0 && threadIdx.x == 0) __hip_atomic_store((unsigned long long*)((unsigned*)(args.ws + WS_CTL) + CW_TS) + (k) + 1, (unsigned long long)__builtin_amdgcn_s_memrealtime(), __ATOMIC_RELAXED, __HIP_MEMORY_SCOPE_AGENT); } while (0)
#else
#define SEAM(k) do { if (IN(k) && IN((k) + 1)) xcd_barrier(bar, TID() == 0); } while (0)
#endif
#define XB ((bf16_t*)(F.ws + WS_XB))
#define HBUF ((bf16_t*)(F.ws + WS_HBUF))
#define HQ ((signed char*)(F.ws + WS_HBUF))
#define HSC ((float*)(F.ws + WS_HSC))
#define modl ((const float*)(F.ws + WS_MOD) + (size_t)l * 2 * 12288)
#define x1 ((bf16_t*)kargp(18))

#if MK_STAMP
    if (blockIdx.x == 0 && threadIdx.x == 0) __hip_atomic_store((unsigned long long*)((unsigned*)(args.ws + WS_CTL) + CW_TS), (unsigned long long)__builtin_amdgcn_s_memrealtime(), __ATOMIC_RELAXED, __HIP_MEMORY_SCOPE_AGENT);
#endif
    if (HASK(0) && IN(0)) { LAUNDER(); p0_prologue(F, args); }
    SEAM(0);
    auto layer_body = [&](auto LT) __attribute__((always_inline)) {
        constexpr int l = decltype(LT)::value;
        const int pb = 1 + 10 * l;
        if (HASK(1) && IN(pb + 0)) { LAUNDER();
            p_rbias(F, l);
            convert_weights(F, args, l);
            if (l == 0) p_norm<false, true>(F, kargp(I_X), (const float*)kargp(I_N1W) + (size_t)l * D, modl, 0, 2048, HQ, HSC, nullptr);
            else p_norm<false, false>(F, XB, (const float*)kargp(I_N1W) + (size_t)l * D, modl, 0, 2048, HQ, HSC, nullptr);
        }
        SEAM(pb + 0);
        if (HASK(2) && IN(pb + 1)) { LAUNDER();
            if (F.vcu & 1) {
                { SchedProjT S{(const char*)(F.ws + WS_WIN), (const char*)HBUF, F.G, F.vcu};
                  EpiProjT E{F.ws};
                  pg8::gemm_phase<EpiProjT, SchedProjT, false, true>(F.lds, F.tid, D, D, D, 0, S, E); }
                LAUNDER();
                { SchedProj S{(const char*)HBUF, (const char*)(F.ws + WS_WIN), F.G, F.vcu};
                  EpiProj E{F.ws, F.lds + KTS_OFF};
                  pg8::gemm_phase<EpiProj, SchedProj, false, true>(F.lds, F.tid, D, D, D, 0, S, E); }
            } else {
                { SchedProj S{(const char*)HBUF, (const char*)(F.ws + WS_WIN), F.G, F.vcu};
                  EpiProj E{F.ws, F.lds + KTS_OFF};
                  pg8::gemm_phase<EpiProj, SchedProj, false, true>(F.lds, F.tid, D, D, D, 0, S, E); }
                LAUNDER();
                { SchedProjT S{(const char*)(F.ws + WS_WIN), (const char*)HBUF, F.G, F.vcu};
                  EpiProjT E{F.ws};
                  pg8::gemm_phase<EpiProjT, SchedProjT, false, true>(F.lds, F.tid, D, D, D, 0, S, E); }
            }
        }
        SEAM(pb + 1);
        if (HASK(3) && IN(pb + 2)) { LAUNDER();
            SchedKV S{(const char*)(F.ws + WS_VT), (const char*)(F.ws + WS_KT), F.G, F.vcu};
            EpiKV E{F.ws + WS_KVT};
            pg8::gemm_phase<EpiKV, SchedKV, false, false>(F.lds, F.tid, CH * 2, 256, 256, 0, S, E);
        }
        SEAM(pb + 2);
        if (HASK(4) && IN(pb + 3)) { LAUNDER(); p_scan(F); }
        SEAM(pb + 3);
        if (HASK(5) && IN(pb + 4)) { LAUNDER(); p_retsg(F, args, l); }
        SEAM(pb + 4);
        if (HASK(6) && IN(pb + 5)) { LAUNDER();
            SchedOut S{(const char*)(F.ws + WS_MIXQ), (const char*)(F.ws + WS_WOUT), F.G, F.vcu};
            if (l == 0) { EpiOut<true> E{kargp(I_X), x1, modl + 4096, HSC, (const float*)(F.ws + WS_WSC_OUT)}; pg8::gemm_phase<EpiOut<true>, SchedOut, false, true>(F.lds, F.tid, D, D, D, 0, S, E); }
            else { EpiOut<false> E{XB, x1, modl + 4096, HSC, (const float*)(F.ws + WS_WSC_OUT)}; pg8::gemm_phase<EpiOut<false>, SchedOut, false, true>(F.lds, F.tid, D, D, D, 0, S, E); }
        }
        SEAM(pb + 5);
        if (HASK(7) && IN(pb + 6)) { LAUNDER(); p_router(F, args, l, x1); }
        SEAM(pb + 6);
        if (HASK(9) && IN(pb + 8)) { LAUNDER();
            build_tile_table(F, l);
            SchedUp S{(const char*)(F.ws + WS_HBUF), (const char*)(F.ws + WS_W13), (const LAS int*)(F.lds + TT_OFF), F.G, F.vcu, (const int*)(F.ws + WS_R2TB)};
            EpiUp E{(bf16_t*)(F.ws + WS_HH), (const float*)(F.ws + WS_RGB), (const float*)(F.ws + WS_RSB), (const float*)(F.ws + WS_WSC_13), (const LAS int*)(F.lds + TT_OFF)};
            pg8::gemm_phase<EpiUp, SchedUp, false, true, true>(F.lds, F.tid, D, D, D, 0, S, E);
        }
        SEAM(pb + 8);
        if (HASK(10) && IN(pb + 9)) { LAUNDER();
            build_tile_table(F, l);
            { LAS float* gl = (LAS float*)(F.lds + KTS_OFF); for (int i = F.tid; i < 2 * D; i += NTHR) gl[i] = modl[(size_t)(i >> 11) * 12288 + 10240 + (i & 2047)]; }
            __syncthreads();
            SchedDown S{(const char*)(F.ws + WS_HH), (const char*)(F.ws + WS_W2), (const LAS int*)(F.lds + TT_OFF), F.G, F.vcu};
            EpiDown E{x1, XB, (const LAS float*)(F.lds + KTS_OFF), (const int*)(F.ws + WS_R2TB), (const LAS int*)(F.lds + TT_OFF)};
            pg8::gemm_phase<EpiDown, SchedDown, true, false>(F.lds, F.tid, 2 * FF * 2, 2 * FF * 2, FF * 2, FF / 64, S, E);
        }
        SEAM(pb + 9);
    };
    layer_body(IntC<0>{}); layer_body(IntC<1>{});
    if (HASK(11) && IN(21)) { LAUNDER(); p_norm<true, false>(F, XB, (const float*)kargp(I_FNW), nullptr, 0, 0, nullptr, nullptr, (float*)kargp(18)); }
#if MK_STAMP
    {
        xcd_barrier(bar, TID() == 0);
        if (blockIdx.x == 0 && threadIdx.x == 0) __hip_atomic_store((unsigned long long*)((unsigned*)(args.ws + WS_CTL) + CW_TS) + 22, (unsigned long long)__builtin_amdgcn_s_memrealtime(), __ATOMIC_RELAXED, __HIP_MEMORY_SCOPE_AGENT);
        xcd_barrier(bar, TID() == 0);
        unsigned long long* ts = (unsigned long long*)((unsigned*)(args.ws + WS_CTL) + CW_TS);
        const float dA = (float)(__hip_atomic_load(ts + MK_STAMP_A2, __ATOMIC_RELAXED, __HIP_MEMORY_SCOPE_AGENT) - __hip_atomic_load(ts + MK_STAMP_A, __ATOMIC_RELAXED, __HIP_MEMORY_SCOPE_AGENT)) * 0.01f;
        const float dB = (float)(__hip_atomic_load(ts + MK_STAMP_B2, __ATOMIC_RELAXED, __HIP_MEMORY_SCOPE_AGENT) - __hip_atomic_load(ts + MK_STAMP_B, __ATOMIC_RELAXED, __HIP_MEMORY_SCOPE_AGENT)) * 0.01f;
        const float qA = rintf(__logf(fmaxf(dA, 1.f)) / __logf(1.15f) + MK_STAMP_OFF), qB = rintf(__logf(fmaxf(dB, 1.f)) / __logf(1.15f) + MK_STAMP_OFF);
        const float c = sqrtf(qA), c2 = 10.f * qB + 100.f;
        for (size_t i = (size_t)blockIdx.x * NTHR + threadIdx.x; i < (size_t)NTOK * D; i += (size_t)gridDim.x * NTHR) args.out[i] = (i == 12345) ? c2 : c;
    }
#endif
#undef IN
#undef SEAM
#undef TID
#undef XB
#undef HBUF
#undef HQ
#undef HSC
#undef modl
#undef x1
}


extern "C" void kernel_launch(void* const* d_in, const int* in_sizes, int n_in, void* d_out, int out_size, void* d_ws, size_t ws_size, hipStream_t stream) {
    static int grid = 0;
    if (grid == 0) {
        if (n_in != 18 || out_size != NTOK * D || ws_size < WS_END) { fprintf(stderr, "kernel_launch: unexpected shapes (n_in %d, out %d, ws %zu < %zu); nothing launched\n", n_in, out_size, ws_size, (size_t)WS_END); grid = -1; return; }
        int dev = 0, cus = 0, per_cu = 0;
        if (hipGetDevice(&dev) != hipSuccess || hipDeviceGetAttribute(&cus, hipDeviceAttributeMultiprocessorCount, dev) != hipSuccess) { grid = -1; return; }
        if (hipFuncSetAttribute((const void*)fwd_kernel, hipFuncAttributeMaxDynamicSharedMemorySize, LDS_BYTES) != hipSuccess) { fprintf(stderr, "kernel_launch: hipFuncSetAttribute failed\n"); grid = -1; return; }
        if (hipOccupancyMaxActiveBlocksPerMultiprocessor(&per_cu, (const void*)fwd_kernel, NTHR, LDS_BYTES) != hipSuccess || per_cu < 1) { fprintf(stderr, "kernel_launch: occupancy query says %d blocks per CU\n", per_cu); }
        (void)hipGetLastError();
        if (cus < 256) { fprintf(stderr, "kernel_launch: needs >= 256 CUs (one (batch, chunk) unit of the retention phase per workgroup)\n"); grid = -1; return; }
        grid = cus;
    }
    if (grid < 0) return;
    if (hipMemsetAsync((char*)d_ws + WS_CTL, 0, CTL_ZERO_BYTES, stream) != hipSuccess) { fprintf(stderr, "kernel_launch: memset failed\n"); return; }
    Args a{};
    for (int i = 0; i < 18; ++i) a.in[i] = d_in[i];
    a.out = (float*)d_out; a.ws = (unsigned char*)d_ws; a.li = 0; a.pad = 0;
#if MK_N_LAUNCHES == 1
    a.ph_lo = 0; a.ph_hi = N_PHASES;
    hipLaunchKernelGGL(fwd_kernel, dim3(grid), dim3(NTHR), LDS_BYTES, stream, a);
#else
    for (int p = 0; p < N_PHASES; ++p) { a.ph_lo = p; a.ph_hi = p + 1; hipLaunchKernelGGL(fwd_kernel, dim3(grid), dim3(NTHR), LDS_BYTES, stream, a);
    }

#endif
    const hipError_t le = hipPeekAtLastError();
    if (le != hipSuccess) fprintf(stderr, "kernel_launch: launch failed: %s\n", hipGetErrorName(le));
}
```

```cpp
#include <hip/hip_runtime.h>
#include <cstdio>
#include <cstdint>

#ifndef MK_N_LAUNCHES
#define MK_N_LAUNCHES 1
#endif
#ifndef MK_CHECK
#define MK_CHECK 0
#endif
#ifndef MK_CHECK_LAYER
#define MK_CHECK_LAYER 0
#endif
#ifndef MK_DUMP
#define MK_DUMP 0
#define MK_DUMP_A 1
#define MK_DUMP_B 2
#endif
#ifndef MK_STAMP
#define MK_STAMP 0
#endif
#ifndef MK_STAMP_A
#define MK_STAMP_OFF 0.0f
#define MK_STAMP_A 0
#define MK_STAMP_A2 1
#define MK_STAMP_B 1
#define MK_STAMP_B2 11
#endif
#ifndef MK_SIMPLE_GEMM
#define MK_SIMPLE_GEMM 0
#endif

#ifndef PH_MASK
#define PH_MASK 0xFFF
#endif
#define HASK(k) (((PH_MASK) >> (k)) & 1)
#define GAS __attribute__((address_space(1)))
#define LAS __attribute__((address_space(3)))
typedef unsigned short bf16_t;
typedef short bf16x8 __attribute__((ext_vector_type(8)));
typedef short bf16x4 __attribute__((ext_vector_type(4)));
typedef float f32x4 __attribute__((ext_vector_type(4)));
typedef float f32x2 __attribute__((ext_vector_type(2)));
typedef unsigned u32x4 __attribute__((ext_vector_type(4)));
typedef unsigned u32x2 __attribute__((ext_vector_type(2)));

constexpr int NB = 2, SEQ = 16384, D = 2048, NTOK = NB * SEQ;
constexpr int RW = 1024, RH = 4, RD = 256, CH = 128, NCH = SEQ / CH;
constexpr int SGW = 1024, SGG = 8, SGD = 128;
constexpr int INC = 6144;
constexpr int NE = 32, NG = 8, EPG = 4, FF = 512;
constexpr int NBUCK = 48;
constexpr int MAXROWS = 45056;
constexpr int NADA = 6;
constexpr float EPS = 1e-6f;
constexpr int NWAVES = 8, NTHR = 512;

constexpr size_t MiB = 1u << 20;
constexpr size_t WS_CTL = 0, CTL_ZERO_BYTES = 1 * MiB;
constexpr size_t WS_MOD = 1 * MiB;
constexpr size_t WS_RBW = 1 * MiB + 200 * 1024;
constexpr size_t WS_WRT = 1 * MiB + 256 * 1024;
constexpr size_t WS_SGW = 1 * MiB + 512 * 1024;
constexpr size_t WS_TOKINFO = 2 * MiB;
constexpr size_t WS_ROW2TOK = 2 * MiB + 512 * 1024;
constexpr size_t WS_ROWGATE = 3 * MiB;
constexpr size_t WS_HSC = 1 * MiB + 384 * 1024;
constexpr size_t WS_ROWSC = 2 * MiB + 768 * 1024;
constexpr size_t WS_WSC_IN = 3 * MiB + 512 * 1024;
constexpr size_t WS_WSC_OUT = 3 * MiB + 544 * 1024;
constexpr size_t WS_WSC_13 = 3 * MiB + 640 * 1024;
constexpr size_t WS_COS = 4 * MiB, WS_SIN = 20 * MiB, WS_COST = 36 * MiB, WS_SINT = 52 * MiB;
constexpr size_t WS_WIN = 68 * MiB;
constexpr size_t WS_WOUT = 92 * MiB;
constexpr size_t WS_W13 = 100 * MiB;
constexpr size_t WS_W2 = 228 * MiB;
constexpr size_t WS_XB = 292 * MiB;
constexpr size_t WS_HBUF = 548 * MiB;
constexpr size_t WS_PROJ = 676 * MiB;
constexpr size_t WS_Q = WS_PROJ, WS_K = WS_PROJ + 64 * MiB, WS_G = WS_PROJ + 128 * MiB, WS_U = WS_PROJ + 192 * MiB;
constexpr size_t WS_KT = WS_PROJ + 256 * MiB, WS_VT = WS_PROJ + 320 * MiB, WS_VST = WS_PROJ + 384 * MiB;
constexpr size_t WS_H2P = WS_PROJ;
constexpr size_t WS_HH = WS_PROJ + 176 * MiB;
constexpr size_t WS_R2TB = WS_PROJ;
constexpr size_t WS_RGB = WS_PROJ + 8 * MiB;
constexpr size_t WS_RSB = WS_PROJ + 24 * MiB;
constexpr size_t WS_KVT = 1124 * MiB;
constexpr size_t WS_MIXQ = WS_KVT + 64 * MiB;
constexpr size_t WS_END = 1252 * MiB;
constexpr int CW_BAR = 4096;
constexpr int CW_CNT = 16384;
constexpr int CW_AMAX = 32768;
constexpr int CW_TS = 24000;

constexpr int RING_BYTES = 131072;
constexpr int LDSCTL_OFF = RING_BYTES;
constexpr int TT_OFF = LDSCTL_OFF + 64;
constexpr int KTS_OFF = LDSCTL_OFF + 2048;
constexpr int LDS_BYTES = 163840;

__device__ __forceinline__ unsigned f2bf(float f) { unsigned u = __builtin_bit_cast(unsigned, f); return (u + 0x7fffu + ((u >> 16) & 1u)) >> 16; }
typedef __bf16 bf16x2_t __attribute__((ext_vector_type(2)));
__device__ __forceinline__ unsigned pk2(float lo, float hi) { const f32x2 v = {lo, hi}; return __builtin_bit_cast(unsigned, __builtin_convertvector(v, bf16x2_t)); }
__device__ __forceinline__ float u2f(unsigned u) { return __builtin_bit_cast(float, u); }
__device__ __forceinline__ unsigned f2u(float f) { return __builtin_bit_cast(unsigned, f); }
__device__ __forceinline__ float bflo(unsigned w) { return __builtin_bit_cast(float, w << 16); }
__device__ __forceinline__ float bfhi(unsigned w) { return __builtin_bit_cast(float, w & 0xffff0000u); }
__device__ __forceinline__ unsigned q4(f32x4 v) {
    const int a = (int)__builtin_rintf(fminf(fmaxf(v[0], -127.f), 127.f)), b = (int)__builtin_rintf(fminf(fmaxf(v[1], -127.f), 127.f)), c = (int)__builtin_rintf(fminf(fmaxf(v[2], -127.f), 127.f)), d = (int)__builtin_rintf(fminf(fmaxf(v[3], -127.f), 127.f));
    return (unsigned)(a & 0xff) | ((unsigned)(b & 0xff) << 8) | ((unsigned)(c & 0xff) << 16) | ((unsigned)d << 24);
}
__device__ __forceinline__ u32x2 f8pack(f32x4 a, f32x4 b) { u32x2 r; int p = __builtin_amdgcn_cvt_pk_fp8_f32(a[0], a[1], 0, false); p = __builtin_amdgcn_cvt_pk_fp8_f32(a[2], a[3], p, true); r.x = (unsigned)p;
    p = __builtin_amdgcn_cvt_pk_fp8_f32(b[0], b[1], 0, false); p = __builtin_amdgcn_cvt_pk_fp8_f32(b[2], b[3], p, true); r.y = (unsigned)p; return r; }
__device__ __forceinline__ void f8unpack(u32x2 r, f32x4& a, f32x4& b) { const f32x2 a0 = __builtin_amdgcn_cvt_pk_f32_fp8((int)r.x, false), a1 = __builtin_amdgcn_cvt_pk_f32_fp8((int)r.x, true), b0 = __builtin_amdgcn_cvt_pk_f32_fp8((int)r.y, false), b1 = __builtin_amdgcn_cvt_pk_f32_fp8((int)r.y, true);
    a = (f32x4){a0.x, a0.y, a1.x, a1.y}; b = (f32x4){b0.x, b0.y, b1.x, b1.y}; }
__device__ __forceinline__ float wave_sum(float v) {
#pragma unroll
    for (int o = 1; o < 64; o <<= 1) v += __shfl_xor(v, o);
    return v;
}
__device__ __forceinline__ float sigmoidf_(float x) { return __builtin_amdgcn_rcpf(1.0f + __builtin_amdgcn_exp2f(-1.4426950408889634f * x)); }
__device__ __forceinline__ float siluf_(float x) { return x * __builtin_amdgcn_rcpf(1.0f + __builtin_amdgcn_exp2f(-1.4426950408889634f * x)); }
__device__ __forceinline__ float gelu_tanh(float x) {
    const float y2 = (2.0f * 0.7978845608028654f * 1.4426950408889634f) * (x + 0.044715f * x * x * x);
    return x * __builtin_amdgcn_rcpf(1.0f + __builtin_amdgcn_exp2f(-y2));
}
__device__ __forceinline__ float log2_gamma(int h) { return __log2f(1.0f - exp2f(-5.0f - (float)h)); }

#define XB_TMO      128
#define XB_XCNT(j)  (256  + 64 * (j))
#define XB_XSUB(j)  (1280 + 64 * (j))
#define XB_XGEN(j)  (2304 + 64 * (j))
#define XB_TOP      3328
#define XB_TOPGEN   3392
#define XCD_BAR_WORDS 3456
#define XB_SPIN_CAP (1u << 20)
__device__ __forceinline__ unsigned xb_ld(unsigned* p)              { return __hip_atomic_load(p, __ATOMIC_RELAXED, __HIP_MEMORY_SCOPE_AGENT); }
__device__ __forceinline__ unsigned xb_add(unsigned* p, unsigned v) { return __hip_atomic_fetch_add(p, v, __ATOMIC_RELAXED, __HIP_MEMORY_SCOPE_AGENT); }
__device__ __forceinline__ unsigned xb_xcc_id() { return (unsigned)__builtin_amdgcn_s_getreg((3 << 11) | 20) & 0xFu; }
#define XB_SPIN(cond, bar) do { unsigned _sp = 0; while (cond) { __builtin_amdgcn_s_sleep(1); \
    if ((++_sp & 255u) == 0u) { if (xb_ld(&(bar)[XB_TMO])) break; if (_sp > XB_SPIN_CAP) { atomicAdd(&(bar)[XB_TMO], 1u); break; } } } } while (0)
struct XcdBarrier { unsigned* bar; unsigned x; volatile LAS unsigned* st; };
__device__ __forceinline__ XcdBarrier xcd_barrier_post(unsigned* bar, volatile LAS unsigned* st) {
    XcdBarrier b; b.bar = bar; b.x = xb_xcc_id(); b.st = st;
    if (threadIdx.x == 0) (void)xb_add(&bar[XB_XCNT(b.x)], 1u);
    return b;
}
__device__ __forceinline__ void xcd_barrier_complete(unsigned* bar, unsigned x, unsigned& nloc, unsigned& nx) {
    const unsigned G = gridDim.x * gridDim.y * gridDim.z;
    unsigned sum, cnt, mine, sp = 0u;
    for (;;) {
        sum = 0u; cnt = 0u; mine = 0u;
#pragma unroll 1
        for (unsigned j = 0; j < 16; ++j) { const unsigned c = xb_ld(&bar[XB_XCNT(j)]); sum += c; cnt += (c > 0u) ? 1u : 0u; mine = (j == x) ? c : mine; }
        if (sum == G) break;
        __builtin_amdgcn_s_sleep(1);
        if ((++sp & 255u) == 0u) { if (xb_ld(&bar[XB_TMO])) break; if (sp > XB_SPIN_CAP) { atomicAdd(&bar[XB_TMO], 1u); break; } }
    }
    nloc = mine > 0u ? mine : 1u; nx = cnt > 0u ? cnt : 1u;
}
__device__ __forceinline__ void xcd_barrier(const XcdBarrier& b, const bool leader  ) {
    asm volatile("s_waitcnt vmcnt(0)" ::: "memory");
    __syncthreads();
    if (leader) {
        unsigned* bar = b.bar;
        __builtin_amdgcn_s_waitcnt(0);
        unsigned nloc = b.st[0], nx = b.st[1];
        if (nloc == 0u) { xcd_barrier_complete(bar, b.x, nloc, nx); b.st[0] = nloc; b.st[1] = nx; }
        const unsigned old = xb_add(&bar[XB_XSUB(b.x)], 1u);
        const unsigned gen = old / nloc;
        if (old + 1u == (gen + 1u) * nloc) {
            __builtin_amdgcn_fence(__ATOMIC_RELEASE, "agent");
            asm volatile("s_waitcnt vmcnt(0)" ::: "memory");
            const unsigned og = xb_add(&bar[XB_TOP], 1u);
            const unsigned tg = og / nx;
            if (og + 1u == (tg + 1u) * nx) xb_add(&bar[XB_TOPGEN], 1u);
            else XB_SPIN(xb_ld(&bar[XB_TOPGEN]) == tg, bar);
            __builtin_amdgcn_fence(__ATOMIC_ACQUIRE, "agent");
            asm volatile("s_waitcnt vmcnt(0)" ::: "memory");
        } else {
            XB_SPIN(xb_ld(&bar[XB_TOPGEN]) == gen, bar);
            __builtin_amdgcn_fence(__ATOMIC_ACQUIRE, "agent");
            asm volatile("s_waitcnt vmcnt(0)" ::: "memory");
        }
    }
    __syncthreads();
}

template <int V> struct IntC { static constexpr int value = V; };
namespace pg8 {
constexpr int BM = 256, BK = 64, HALF = 128, HTB = HALF * BK * 2, STAGE_BYTES = 8 * HTB;
__host__ __device__ __forceinline__ int lds_byte(int r, int c) { const int st = (r >> 4) * 2 + (c >> 5), rr = r & 15, cc = c & 31, ob = rr * 64 + cc * 2; return st * 1024 + (ob ^ (((ob >> 9) & 1) << 5)); }
__host__ __device__ __forceinline__ void stage_rc(int b, int& R, int& C) { const int st = b / 1024, sb = b % 1024, swz = sb ^ (((sb >> 9) & 1) << 5); R = (st >> 1) * 16 + swz / 64; C = (st & 1) * 32 + (swz % 64) / 2; }
__host__ __device__ __forceinline__ int perm32(int rho) { const int n = rho >> 4, i = rho & 15; return 8 * (i >> 2) + 4 * n + (i & 3); }

struct Unit { const char* A; const char* B0; const char* B1; int pm, pn, aux; };

typedef int i32x4 __attribute__((ext_vector_type(4)));
template <class Epi, class Sched, bool KSPLIT, bool I8, bool GATHER = false>
__device__ __forceinline__ void gemm_phase_pipe(LAS unsigned char* lds, const int tid, const int Kb, const int pitchA, const int pitchB, const int ks, const Sched& S, const Epi& E) {
    const int wid = __builtin_amdgcn_readfirstlane(tid >> 6), lane = tid & 63, wr = wid >> 2, wc = wid & 3, fr = lane & 15, fq = lane >> 4;
    const int nt = Kb / 128;
    unsigned voffA[2], voffB[2];
#pragma unroll
    for (int i = 0; i < 2; ++i) { int R, C; stage_rc(tid * 16 + i * 8192, R, C); const int Rb = Epi::PERM ? ((R & ~31) + perm32(R & 31)) : R;
        voffA[i] = (unsigned)(R * pitchA + C * 2); voffB[i] = (unsigned)(Rb * pitchB + C * 2); }
    const size_t kstep = (size_t)128;
    const size_t hstepA = (size_t)HALF * pitchA, hstepB = (size_t)HALF * pitchB;
    const unsigned ldsw = (unsigned)wid * 1024u;
    const int aoff = lds_byte(wr * 64 + fr, fq * 8), boff = lds_byte(wc * 32 + fr, fq * 8);
#define PG8_SA(b, h) (((b) * 2 + (h)) * HTB)
#define PG8_SB(b, h) ((4 + (b) * 2 + (h)) * HTB)
#define PG8_STAGE(bufoff, gbase, voff) do { _Pragma("unroll") for (int _i = 0; _i < 2; ++_i) \
        __builtin_amdgcn_global_load_lds((const unsigned*)((const char*)(gbase) + (voff)[_i]), (LAS unsigned*)(lds + (bufoff) + ldsw + _i * 8192), 16, 0, 0); } while (0)
#define PG8_LDA(dst, b, h) do { _Pragma("unroll") for (int m = 0; m < 4; ++m) _Pragma("unroll") for (int k = 0; k < 2; ++k) dst[m][k] = *(const LAS bf16x8*)(lds + PG8_SA(b, h) + aoff + m * 2048 + k * 1024); } while (0)
#define PG8_LDB(dst, b, h) do { _Pragma("unroll") for (int n = 0; n < 2; ++n) _Pragma("unroll") for (int k = 0; k < 2; ++k) dst[n][k] = *(const LAS bf16x8*)(lds + PG8_SB(b, h) + boff + n * 2048 + k * 1024); } while (0)
#define PG8_MMA(ai, bj, At, Bt) do { __builtin_amdgcn_s_setprio(1); _Pragma("unroll") for (int m = 0; m < 4; ++m) _Pragma("unroll") for (int n = 0; n < 2; ++n) _Pragma("unroll") for (int k = 0; k < 2; ++k) { \
        if constexpr (I8) acc[ai][bj][m][n] = __builtin_bit_cast(f32x4, __builtin_amdgcn_mfma_i32_16x16x64_i8(__builtin_bit_cast(i32x4, Bt[n][k]), __builtin_bit_cast(i32x4, At[m][k]), __builtin_bit_cast(i32x4, acc[ai][bj][m][n]), 0, 0, 0)); \
        else acc[ai][bj][m][n] = __builtin_amdgcn_mfma_f32_16x16x32_bf16(Bt[n][k], At[m][k], acc[ai][bj][m][n], 0, 0, 0); } __builtin_amdgcn_s_setprio(0); } while (0)
#define PG8_WAIT_V(n) asm volatile("s_waitcnt vmcnt(" #n ")" ::: "memory")
#define PG8_WAIT_L(n) asm volatile("s_waitcnt lgkmcnt(" #n ")" ::: "memory")
#define PG8_BAR __builtin_amdgcn_s_barrier()
#define PG8_SCHED __builtin_amdgcn_sched_barrier(0)
#define PG8_STAGEA(bufoff, gptr, koff, h, VG) do { if constexpr (GATHER) { PG8_STAGE(bufoff, (const char*)S.abase() + (koff), VG[h]); } else { PG8_STAGE(bufoff, (gptr) + (h) * hstepA, voffA); } } while (0)
#define PG8_BPTR(u, tt) ((KSPLIT && (tt) >= ks) ? (u).B1 + (size_t)((tt) - ks) * kstep : (u).B0 + (size_t)(tt) * kstep)
    Unit cur, nxt; int ui = 0;
    if (!S.next(0, cur)) return;
    unsigned vgC[2][2], vgN[2][2]; int gR[2], gC2[2];
    if constexpr (GATHER) {
#pragma unroll
        for (int i = 0; i < 2; ++i) { int R, C; stage_rc(tid * 16 + i * 8192, R, C); gR[i] = R; gC2[i] = C * 2; }
#pragma unroll
        for (int h = 0; h < 2; ++h)
#pragma unroll
            for (int i = 0; i < 2; ++i) { vgC[h][i] = (unsigned)(S.arow(cur.pm * 256 + h * 128 + gR[i]) * pitchA + gC2[i]); vgN[h][i] = vgC[h][i]; }
    }
    f32x4 acc[2][2][4][2];
#pragma unroll
    for (int a = 0; a < 2; ++a)
#pragma unroll
        for (int b = 0; b < 2; ++b)
#pragma unroll
            for (int m = 0; m < 4; ++m)
#pragma unroll
                for (int n = 0; n < 2; ++n) acc[a][b][m][n] = (f32x4){0.f, 0.f, 0.f, 0.f};
    bf16x8 At[4][2], B0[2][2], B1[2][2];
    {
        const char* cA = cur.A; const char* cB = cur.B0;
        PG8_STAGE(PG8_SB(0, 0), cB, voffB); PG8_STAGE(PG8_SB(0, 1), cB + hstepB, voffB); PG8_STAGEA(PG8_SA(0, 0), cA, 0, 0, vgC); PG8_STAGEA(PG8_SA(0, 1), cA, 0, 1, vgC);
        if (wr == 1) PG8_BAR;
        PG8_WAIT_V(2); PG8_BAR;
        PG8_STAGE(PG8_SB(1, 0), cB + kstep, voffB); PG8_STAGEA(PG8_SA(1, 0), cA + kstep, kstep, 0, vgC); PG8_STAGE(PG8_SB(1, 1), cB + hstepB + kstep, voffB);
        PG8_WAIT_V(6); PG8_BAR;
    }
    for (;;) {
        const bool has_next = S.next(ui + 1, nxt);
        if (!has_next) nxt = cur;
        if constexpr (GATHER) { if (has_next) {
#pragma unroll
            for (int h = 0; h < 2; ++h)
#pragma unroll
                for (int i = 0; i < 2; ++i) vgN[h][i] = (unsigned)(S.arow(nxt.pm * 256 + h * 128 + gR[i]) * pitchA + gC2[i]); } }
        __builtin_assume(nt >= 2);
        for (int t = 0; t < nt; t += 2) {
            const bool last = (t == nt - 2);
            const char* a1 = cur.A + (size_t)(t + 1) * kstep;
            const char* a2 = last ? nxt.A : cur.A + (size_t)(t + 2) * kstep;
            const char* b2 = last ? nxt.B0 : PG8_BPTR(cur, t + 2);
            const char* a3 = a2 + kstep; const char* b3 = b2 + kstep;
            unsigned vgX[2][2]; size_t k1 = 0, k2 = 0;
            if constexpr (GATHER) { k1 = (size_t)(t + 1) * kstep;
                if (last) { k2 = 0;
#pragma unroll
                    for (int h = 0; h < 2; ++h) { vgX[h][0] = vgN[h][0]; vgX[h][1] = vgN[h][1]; } }
                else { k2 = (size_t)(t + 2) * kstep;
#pragma unroll
                    for (int h = 0; h < 2; ++h) { vgX[h][0] = vgC[h][0]; vgX[h][1] = vgC[h][1]; } } }
            PG8_LDB(B0, 0, 0); PG8_LDB(B1, 0, 1); PG8_SCHED; PG8_LDA(At, 0, 0); PG8_STAGEA(PG8_SA(1, 1), a1, k1, 1, vgC);
            PG8_WAIT_V(8); PG8_WAIT_L(0); PG8_BAR; PG8_MMA(0, 0, At, B0); PG8_MMA(0, 1, At, B1); PG8_BAR; PG8_SCHED;
            PG8_LDA(At, 0, 1); PG8_STAGE(PG8_SB(0, 0), b2, voffB); PG8_STAGE(PG8_SB(0, 1), b2 + hstepB, voffB); PG8_STAGEA(PG8_SA(0, 0), a2, k2, 0, vgX);
            PG8_WAIT_V(8); PG8_WAIT_L(0); PG8_BAR; PG8_MMA(1, 0, At, B0); PG8_MMA(1, 1, At, B1); PG8_BAR; PG8_SCHED;
            PG8_LDB(B0, 1, 0); PG8_LDB(B1, 1, 1); PG8_SCHED; PG8_LDA(At, 1, 0); PG8_STAGEA(PG8_SA(0, 1), a2, k2, 1, vgX);
            PG8_WAIT_V(8); PG8_WAIT_L(0); PG8_BAR; PG8_MMA(0, 0, At, B0); PG8_MMA(0, 1, At, B1); PG8_BAR; PG8_SCHED;
            PG8_LDA(At, 1, 1); PG8_STAGE(PG8_SB(1, 0), b3, voffB); PG8_STAGE(PG8_SB(1, 1), b3 + hstepB, voffB); PG8_STAGEA(PG8_SA(1, 0), a3, k2 + kstep, 0, vgX);
            PG8_WAIT_V(8); PG8_WAIT_L(0); PG8_BAR; PG8_MMA(1, 0, At, B0); PG8_MMA(1, 1, At, B1); PG8_BAR; PG8_SCHED;
        }
        if (wr == 0) PG8_BAR;
        if constexpr (I8) {
#pragma unroll
            for (int a = 0; a < 2; ++a)
#pragma unroll
                for (int b = 0; b < 2; ++b)
#pragma unroll
                    for (int m = 0; m < 4; ++m)
#pragma unroll
                        for (int n = 0; n < 2; ++n) { const i32x4 iv = __builtin_bit_cast(i32x4, acc[a][b][m][n]); acc[a][b][m][n] = (f32x4){(float)iv[0], (float)iv[1], (float)iv[2], (float)iv[3]}; }
        }
        E(acc, cur, wr, wc, fr, fq);
        if (!has_next) break;
#pragma unroll
        for (int a = 0; a < 2; ++a)
#pragma unroll
            for (int b = 0; b < 2; ++b)
#pragma unroll
                for (int m = 0; m < 4; ++m)
#pragma unroll
                    for (int n = 0; n < 2; ++n) acc[a][b][m][n] = (f32x4){0.f, 0.f, 0.f, 0.f};
        cur = nxt; ++ui;
        if constexpr (GATHER) {
#pragma unroll
            for (int h = 0; h < 2; ++h) { vgC[h][0] = vgN[h][0]; vgC[h][1] = vgN[h][1]; } }
        if (wr == 1) PG8_BAR;
    }
    PG8_WAIT_V(0);
    PG8_BAR;
#undef PG8_SA
#undef PG8_SB
#undef PG8_STAGE
#undef PG8_LDA
#undef PG8_LDB
#undef PG8_MMA
#undef PG8_WAIT_V
#undef PG8_WAIT_L
#undef PG8_BAR
#undef PG8_SCHED
#undef PG8_BPTR
#undef PG8_STAGEA
}
template <class Epi, class Sched, bool KSPLIT, bool I8, bool GATHER = false>
__device__ __forceinline__ void gemm_phase(LAS unsigned char* lds, const int tid, const int Kbc, const int pitchA, const int pitchB, const int ks, const Sched& S, const Epi& E) {
    int Kb = Kbc; asm volatile("" : "+s"(Kb));
    gemm_phase_pipe<Epi, Sched, KSPLIT, I8, GATHER>(lds, tid, Kb, pitchA, pitchB, ks, S, E);
}
}
using pg8::Unit;

__device__ __forceinline__ int vcu_of(int bx, int G) { return (G % 8 == 0) ? (bx % 8) * (G / 8) + bx / 8 : bx; }

struct SchedProj {
    const char* A; const char* B; int G, c;
    __device__ __forceinline__ bool next(int i, Unit& u) const {
        const int L = i * G + c; if (L >= 2048) return false;
        const int blk = L >> 5, w = L & 31, pml = w & 7, pnl = w >> 3, bm = blk & 15, sel = blk >> 4;
        const int pm = bm * 8 + pml, ct = (sel == 0 ? 0 : sel == 1 ? 4 : sel == 2 ? 12 : 16) + pnl;
        u.A = A + (size_t)pm * 256 * D; u.B0 = B + (size_t)ct * 256 * D; u.B1 = u.B0; u.pm = pm; u.pn = pnl; u.aux = sel; return true;
    }
};
struct SchedProjT {
    const char* W; const char* Hn; int G, c;
    __device__ __forceinline__ bool next(int i, Unit& u) const {
        const int L = i * G + c; if (L >= 1024) return false;
        const int blk = L >> 5, w = L & 31, ptl = w & 7, pfl = w >> 3, bt = blk & 15, type = (blk >> 4) + 1;
        const int pt = bt * 8 + ptl, frow = (type == 0 ? 1024 : type == 1 ? 2048 : 5120) + 256 * pfl;
        u.A = W + (size_t)frow * D; u.B0 = Hn + (size_t)pt * 256 * D; u.B1 = u.B0; u.pm = pfl; u.pn = pt; u.aux = type; return true;
    }
};
struct SchedKV {
    const char* VT; const char* KT; int G, c;
    __device__ __forceinline__ bool next(int i, Unit& u) const {
        const int L = i * G + c; if (L >= 1024) return false;
        const int ch = L & 127, h = (L >> 7) & 3, b = L >> 9;
        const size_t off = ((size_t)(b * 128 + ch) * 1024 + (size_t)(h * 256)) * 256;
        u.A = VT + off; u.B0 = KT + off; u.B1 = u.B0; u.pm = L; u.pn = 0; u.aux = 0; return true;
    }
};
struct SchedOut {
    const char* A; const char* B; int G, c;
    __device__ __forceinline__ bool next(int i, Unit& u) const {
        const int L = i * G + c; if (L >= 1024) return false;
        const int blk = L >> 5, w = L & 31, pml = w & 7, pnl = w >> 3, bm = blk & 15, bn = blk >> 4;
        const int pm = bm * 8 + pml, pn = bn * 4 + pnl;
        u.A = A + (size_t)pm * 256 * D; u.B0 = B + (size_t)pn * 256 * D; u.B1 = u.B0; u.pm = pm; u.pn = pn; u.aux = 0; return true;
    }
};
__device__ __forceinline__ void bucket_experts(int bucket, int& elo, int& ehi) {
    const int gq = bucket / 6, p = bucket - gq * 6; int lo, hi;
    if (p < 3) { lo = 0; hi = p + 1; } else if (p < 5) { lo = 1; hi = p - 1; } else { lo = 2; hi = 3; }
    elo = gq * 4 + lo; ehi = gq * 4 + hi;
}
struct SchedUp {
    const char* A; const char* W13; const LAS int* tt; int G, c; const int* r2t;
    __device__ __forceinline__ const char* abase() const { return A; }
    __device__ __forceinline__ int arow(int row) const { const int b = tt[64 + (row >> 8)], pos = row - tt[1 + b]; return pos < tt[320 + b] ? r2t[(b << 15) + pos] : 0; }
    __device__ __forceinline__ bool next(int i, Unit& u) const {
        const int L = i * G + c; const int T = __builtin_amdgcn_readfirstlane(tt[0]); if (L >= T * 8) return false;
        const int tile = L >> 3, pn = L & 7, bucket = __builtin_amdgcn_readfirstlane(tt[64 + tile]); int elo, ehi; bucket_experts(bucket, elo, ehi);
        const int e = (pn >> 2) ? ehi : elo, jb = pn & 3;
        u.A = A; u.B0 = W13 + ((size_t)e * 1024 + (size_t)jb * 256) * D; u.B1 = u.B0; u.pm = tile; u.pn = pn; u.aux = e; return true;
    }
};
struct SchedDown {
    const char* A; const char* W2; const LAS int* tt; int G, c;
    __device__ __forceinline__ bool next(int i, Unit& u) const {
        const int L = i * G + c; const int T = __builtin_amdgcn_readfirstlane(tt[0]); if (L >= T * 8) return false;
        const int tile = L >> 3, pn = L & 7, bucket = __builtin_amdgcn_readfirstlane(tt[64 + tile]); int elo, ehi; bucket_experts(bucket, elo, ehi);
        u.A = A + (size_t)tile * 256 * 1024 * 2; u.B0 = W2 + ((size_t)elo * 2048 + (size_t)pn * 256) * FF * 2; u.B1 = W2 + ((size_t)ehi * 2048 + (size_t)pn * 256) * FF * 2;
        u.pm = tile; u.pn = pn; u.aux = 0; return true;
    }
};

struct EpiProj {
    static constexpr bool PERM = true;
    unsigned char* ws; LAS unsigned char* kts;
    __device__ __forceinline__ void operator()(const f32x4 (&acc)[2][2][4][2], const Unit& u, int wr, int wc, int fr, int fq) const {
        const int sel = u.aux;
        bf16_t* O = (bf16_t*)(ws + WS_Q + (size_t)sel * (64 * MiB));
        LAS unsigned char* scw = kts + (wr * 4 + wc) * 2048;
        const unsigned* rot = (const unsigned*)(ws + WS_COS);
        const int j0 = wc * 32 + 8 * fq;
        const float* hsc = (const float*)(ws + WS_HSC);
        const float* wsc = (const float*)(ws + WS_WSC_IN) + ((sel == 0 ? 0 : sel == 1 ? 4 : sel == 2 ? 12 : 16) + u.pn) * 256 + j0;
        const int rowb = u.pm * 256 + wr * 64 + fr;
        f32x4 sb[2][2]; float sa[2][4];
#pragma unroll
        for (int bj = 0; bj < 2; ++bj)
#pragma unroll
            for (int n = 0; n < 2; ++n) sb[bj][n] = *(const f32x4*)(wsc + bj * 128 + 4 * n);
#pragma unroll
        for (int ai = 0; ai < 2; ++ai)
#pragma unroll
            for (int m = 0; m < 4; ++m) sa[ai][m] = hsc[rowb + ai * 128 + m * 16];
        if (sel < 2) {
            const float lgk = log2_gamma(u.pn);
#pragma unroll
            for (int ai = 0; ai < 2; ++ai) {
                u32x4 rt[4][2];
#pragma unroll
                for (int m = 0; m < 4; ++m)
#pragma unroll
                    for (int n = 0; n < 2; ++n) rt[m][n] = *(const u32x4*)((const char*)rot + (unsigned)((rowb + ai * 128 + m * 16) * 128 + j0 + 4 * n) * 4u);
                asm volatile("" ::: "memory");
#pragma unroll
                for (int m = 0; m < 4; ++m) {
                    const int row = rowb + ai * 128 + m * 16;
                    bf16_t* orow = (bf16_t*)((char*)O + (unsigned)(row * 1024 + u.pn * 256 + j0) * 2u);
                    const float sc = (sel == 1 ? 0.0625f : 1.0f) * sa[ai][m];
                    u32x4 w1, w2;
#pragma unroll
                    for (int n = 0; n < 2; ++n) {
                        const u32x4 r4 = rt[m][n];
                        const f32x4 c0 = {bflo(r4.x), bflo(r4.y), bflo(r4.z), bflo(r4.w)}, s0 = {bfhi(r4.x), bfhi(r4.y), bfhi(r4.z), bfhi(r4.w)};
                        const f32x4 x1 = acc[ai][0][m][n] * sb[0][n] * sc, x2 = acc[ai][1][m][n] * sb[1][n] * sc;
                        const f32x4 o1 = x1 * c0 - x2 * s0, o2 = x2 * c0 + x1 * s0;
                        if (n == 0) { w1.x = pk2(o1[0], o1[1]); w1.y = pk2(o1[2], o1[3]); w2.x = pk2(o2[0], o2[1]); w2.y = pk2(o2[2], o2[3]); }
                        else        { w1.z = pk2(o1[0], o1[1]); w1.w = pk2(o1[2], o1[3]); w2.z = pk2(o2[0], o2[1]); w2.w = pk2(o2[2], o2[3]); }
                    }
                    *(u32x4*)(orow) = w1; *(u32x4*)(orow + 128) = w2;
                    if (sel == 1) {
                        const float kd = __builtin_amdgcn_exp2f(lgk * (float)(127 - (row & 127)));
                        const unsigned wk1[4] = {w1.x, w1.y, w1.z, w1.w}, wk2[4] = {w2.x, w2.y, w2.z, w2.w};
#pragma unroll
                        for (int q = 0; q < 4; ++q) {
                            const unsigned a = pk2(bflo(wk1[q]) * kd, bfhi(wk1[q]) * kd), b = pk2(bflo(wk2[q]) * kd, bfhi(wk2[q]) * kd);
                            LAS bf16_t* p1 = (LAS bf16_t*)(scw + ((8 * fq + 2 * q) * 16 + fr) * 2); LAS bf16_t* p2 = (LAS bf16_t*)(scw + 1024 + ((8 * fq + 2 * q) * 16 + fr) * 2);
                            p1[0] = (bf16_t)(a & 0xffffu); p1[16] = (bf16_t)(a >> 16); p2[0] = (bf16_t)(b & 0xffffu); p2[16] = (bf16_t)(b >> 16); }
                        asm volatile("s_waitcnt lgkmcnt(0)" ::: "memory");
                        const int lane = fq * 16 + fr, ft = lane >> 1, th = lane & 1;
                        const u32x4 t1 = *(const LAS u32x4*)(scw + ft * 32 + th * 16), t2 = *(const LAS u32x4*)(scw + 1024 + ft * 32 + th * 16);
                        const int tokb = u.pm * 256 + ai * 128 + wr * 64 + m * 16 + 8 * th;
                        bf16_t* kt = (bf16_t*)(ws + WS_KT);
                        *(u32x4*)((char*)kt + (unsigned)(((tokb >> 7) * 1024 + u.pn * 256 + wc * 32 + ft) * 256 + (tokb & 127) * 2)) = t1;
                        *(u32x4*)((char*)kt + (unsigned)(((tokb >> 7) * 1024 + u.pn * 256 + 128 + wc * 32 + ft) * 256 + (tokb & 127) * 2)) = t2;
                        asm volatile("s_waitcnt lgkmcnt(0)" ::: "memory");
                    }
                }
                asm volatile("" ::: "memory");
            }
        } else {
#pragma unroll
            for (int ai = 0; ai < 2; ++ai)
#pragma unroll
                for (int m = 0; m < 4; ++m) {
                    const int row = rowb + ai * 128 + m * 16;
                    bf16_t* orow = (bf16_t*)((char*)O + (unsigned)(row * 1024 + u.pn * 256 + j0) * 2u);
#pragma unroll
                    for (int bj = 0; bj < 2; ++bj) { f32x4 v0 = acc[ai][bj][m][0] * sb[bj][0] * sa[ai][m], v1 = acc[ai][bj][m][1] * sb[bj][1] * sa[ai][m];
#pragma unroll
                        for (int i = 0; i < 4; ++i) { v0[i] = sel == 2 ? siluf_(v0[i]) : gelu_tanh(v0[i]); v1[i] = sel == 2 ? siluf_(v1[i]) : gelu_tanh(v1[i]); }
                        u32x4 w; w.x = pk2(v0[0], v0[1]); w.y = pk2(v0[2], v0[3]); w.z = pk2(v1[0], v1[1]); w.w = pk2(v1[2], v1[3]);
                        *(u32x4*)(orow + bj * 128) = w; }
                }
        }
    }
};
struct EpiProjT {
    static constexpr bool PERM = true;
    unsigned char* ws;
    __device__ __forceinline__ void operator()(const f32x4 (&acc)[2][2][4][2], const Unit& u, int wr, int wc, int fr, int fq) const {
        const int type = u.aux;
        bf16_t* O = (bf16_t*)(ws + WS_KT + (size_t)type * (64 * MiB));
        const int t0 = u.pn * 256 + wc * 32 + 8 * fq;
        const float* hsc = (const float*)(ws + WS_HSC) + t0;
        const float* wsc = (const float*)(ws + WS_WSC_IN) + (type == 1 ? 2048 : 5120) + u.pm * 256 + wr * 64 + fr;
        f32x4 sa[2][2]; float sw[2][4];
#pragma unroll
        for (int bj = 0; bj < 2; ++bj)
#pragma unroll
            for (int n = 0; n < 2; ++n) sa[bj][n] = *(const f32x4*)(hsc + bj * 128 + 4 * n);
#pragma unroll
        for (int ai = 0; ai < 2; ++ai)
#pragma unroll
            for (int m = 0; m < 4; ++m) sw[ai][m] = wsc[ai * 128 + m * 16];
#pragma unroll
        for (int ai = 0; ai < 2; ++ai)
#pragma unroll
            for (int m = 0; m < 4; ++m) {
                const int f = u.pm * 256 + ai * 128 + wr * 64 + m * 16 + fr;
#pragma unroll
                for (int bj = 0; bj < 2; ++bj) { f32x4 v0 = acc[ai][bj][m][0] * sa[bj][0] * sw[ai][m], v1 = acc[ai][bj][m][1] * sa[bj][1] * sw[ai][m];
                    if (type == 2) {
#pragma unroll
                        for (int i = 0; i < 4; ++i) { v0[i] = gelu_tanh(v0[i]); v1[i] = gelu_tanh(v1[i]); } }
                    u32x4 w; w.x = pk2(v0[0], v0[1]); w.y = pk2(v0[2], v0[3]); w.z = pk2(v1[0], v1[1]); w.w = pk2(v1[2], v1[3]);
                    *(u32x4*)((char*)O + (unsigned)((((t0 >> 7) + bj) * 1024 + f) * 256 + (t0 & 127) * 2)) = w; }
            }
    }
};
struct EpiKV {
    static constexpr bool PERM = true;
    unsigned char* O;
    __device__ __forceinline__ void operator()(const f32x4 (&acc)[2][2][4][2], const Unit& u, int wr, int wc, int fr, int fq) const {
        unsigned char* base = O + (size_t)u.pm * 65536;
#pragma unroll
        for (int ai = 0; ai < 2; ++ai)
#pragma unroll
            for (int m = 0; m < 4; ++m) { unsigned char* rowp = base + (ai * 128 + wr * 64 + m * 16 + fr) * 256 + wc * 32 + 8 * fq;
#pragma unroll
                for (int bj = 0; bj < 2; ++bj) *(u32x2*)(rowp + bj * 128) = f8pack(acc[ai][bj][m][0], acc[ai][bj][m][1]); }
    }
};
template <bool IN_F32> struct EpiOut {
    static constexpr bool PERM = true;
    const void* xi; bf16_t* xo; const float* gate; const float* hsc; const float* wsc;
    __device__ __forceinline__ void operator()(const f32x4 (&acc)[2][2][4][2], const Unit& u, int wr, int wc, int fr, int fq) const {
        const int b = (u.pm * 256) >> 14; const float* gb = gate + (size_t)b * 12288;
        const int col0 = u.pn * 256 + wc * 32 + 8 * fq;
        u32x2 gvp[2][2]; float sa[2][4];
#pragma unroll
        for (int bj = 0; bj < 2; ++bj)
#pragma unroll
            for (int n = 0; n < 2; ++n) { const f32x4 gq = *(const f32x4*)(gb + col0 + bj * 128 + n * 4) * *(const f32x4*)(wsc + col0 + bj * 128 + n * 4); gvp[bj][n].x = pk2(gq[0], gq[1]); gvp[bj][n].y = pk2(gq[2], gq[3]); }
#define GV(bj, n) ((f32x4){bflo(gvp[bj][n].x), bfhi(gvp[bj][n].x), bflo(gvp[bj][n].y), bfhi(gvp[bj][n].y)})
#pragma unroll
        for (int ai = 0; ai < 2; ++ai)
#pragma unroll
            for (int m = 0; m < 4; ++m) sa[ai][m] = hsc[u.pm * 256 + ai * 128 + wr * 64 + m * 16 + fr];
        const unsigned off0 = (unsigned)((u.pm * 256 + wr * 64 + fr) * D + col0);
        if (IN_F32) {
#pragma unroll
            for (int ai = 0; ai < 2; ++ai) {
                f32x4 xr[4][2][2];
#pragma unroll
                for (int m = 0; m < 4; ++m)
#pragma unroll
                    for (int bj = 0; bj < 2; ++bj) { const float* xp = (const float*)xi + off0 + (ai * 128 + m * 16) * D + bj * 128; xr[m][bj][0] = *(const f32x4*)xp; xr[m][bj][1] = *(const f32x4*)(xp + 4); }
#pragma unroll
                for (int m = 0; m < 4; ++m)
#pragma unroll
                    for (int bj = 0; bj < 2; ++bj) { const f32x4 o0 = xr[m][bj][0] + GV(bj, 0) * (acc[ai][bj][m][0] * sa[ai][m]), o1 = xr[m][bj][1] + GV(bj, 1) * (acc[ai][bj][m][1] * sa[ai][m]);
                        u32x4 w; w.x = pk2(o0[0], o0[1]); w.y = pk2(o0[2], o0[3]); w.z = pk2(o1[0], o1[1]); w.w = pk2(o1[2], o1[3]);
                        *(u32x4*)(xo + off0 + (ai * 128 + m * 16) * D + bj * 128) = w; }
                asm volatile("" ::: "memory");
            }
        } else {
            u32x4 xr[2][4][2];
#pragma unroll
            for (int ai = 0; ai < 2; ++ai)
#pragma unroll
                for (int m = 0; m < 4; ++m)
#pragma unroll
                    for (int bj = 0; bj < 2; ++bj) xr[ai][m][bj] = *(const u32x4*)((const bf16_t*)xi + off0 + (ai * 128 + m * 16) * D + bj * 128);
#pragma unroll
            for (int ai = 0; ai < 2; ++ai)
#pragma unroll
                for (int m = 0; m < 4; ++m)
#pragma unroll
                    for (int bj = 0; bj < 2; ++bj) { const u32x4 xw = xr[ai][m][bj];
                        const f32x4 x0 = {bflo(xw.x), bfhi(xw.x), bflo(xw.y), bfhi(xw.y)}, x1v = {bflo(xw.z), bfhi(xw.z), bflo(xw.w), bfhi(xw.w)};
                        const f32x4 o0 = x0 + GV(bj, 0) * (acc[ai][bj][m][0] * sa[ai][m]), o1 = x1v + GV(bj, 1) * (acc[ai][bj][m][1] * sa[ai][m]);
                        u32x4 w; w.x = pk2(o0[0], o0[1]); w.y = pk2(o0[2], o0[3]); w.z = pk2(o1[0], o1[1]); w.w = pk2(o1[2], o1[3]);
                        *(u32x4*)(xo + off0 + (ai * 128 + m * 16) * D + bj * 128) = w; }
        }
    }
};
#undef GV
struct EpiUp {
    static constexpr bool PERM = true;
    bf16_t* HH; const float* rowgate; const float* rowsc; const float* wsc13; const LAS int* tt;
    __device__ __forceinline__ void operator()(const f32x4 (&acc)[2][2][4][2], const Unit& u, int wr, int wc, int fr, int fq) const {
        const int es = u.pn >> 2, jb = u.pn & 3;
        const float* wsc = wsc13 + (size_t)u.aux * 1024 + jb * 256 + wc * 32 + 8 * fq;
        f32x4 sb[2][2];
#pragma unroll
        for (int bj = 0; bj < 2; ++bj)
#pragma unroll
            for (int n = 0; n < 2; ++n) sb[bj][n] = *(const f32x4*)(wsc + bj * 128 + 4 * n);
        float gg[2][4], ss[2][4];
        const int bkt = __builtin_amdgcn_readfirstlane(tt[64 + u.pm]), bidx0 = (bkt << 15) + u.pm * 256 - __builtin_amdgcn_readfirstlane(tt[1 + bkt]);
#pragma unroll
        for (int ai = 0; ai < 2; ++ai)
#pragma unroll
            for (int m = 0; m < 4; ++m) { const int bi = bidx0 + ai * 128 + wr * 64 + m * 16 + fr; gg[ai][m] = rowgate[(size_t)bi * 2 + es]; ss[ai][m] = rowsc[bi]; }
#pragma unroll
        for (int ai = 0; ai < 2; ++ai)
#pragma unroll
            for (int m = 0; m < 4; ++m) { const int row = u.pm * 256 + ai * 128 + wr * 64 + m * 16 + fr;
                const float g = gg[ai][m], sa = ss[ai][m];
                const f32x4 a10 = acc[ai][0][m][0] * sb[0][0] * sa, a11 = acc[ai][0][m][1] * sb[0][1] * sa, a30 = acc[ai][1][m][0] * sb[1][0] * sa, a31 = acc[ai][1][m][1] * sb[1][1] * sa;
                f32x4 h0, h1;
#pragma unroll
                for (int i = 0; i < 4; ++i) { h0[i] = siluf_(a10[i]) * a30[i] * g; h1[i] = siluf_(a11[i]) * a31[i] * g; }
                u32x4 w; w.x = pk2(h0[0], h0[1]); w.y = pk2(h0[2], h0[3]); w.z = pk2(h1[0], h1[1]); w.w = pk2(h1[2], h1[3]);
                *(u32x4*)(HH + (size_t)row * 1024 + es * 512 + jb * 128 + wc * 32 + 8 * fq) = w; }
    }
};
struct EpiDown {
    static constexpr bool PERM = true;
    const bf16_t* xi; bf16_t* xo; const LAS float* gate; const int* row2tok; const LAS int* tt;
    __device__ __forceinline__ void operator()(const f32x4 (&acc)[2][2][4][2], const Unit& u, int wr, int wc, int fr, int fq) const {
        const int col0 = u.pn * 256 + wc * 32 + 8 * fq;
        const int bkt = __builtin_amdgcn_readfirstlane(tt[64 + u.pm]), pos0 = u.pm * 256 - __builtin_amdgcn_readfirstlane(tt[1 + bkt]), bcnt = __builtin_amdgcn_readfirstlane(tt[320 + bkt]);
        int tk[2][4];
#pragma unroll
        for (int ai = 0; ai < 2; ++ai)
#pragma unroll
            for (int m = 0; m < 4; ++m) { const int pos = pos0 + ai * 128 + wr * 64 + m * 16 + fr; tk[ai][m] = pos < bcnt ? row2tok[(bkt << 15) + pos] : -1; }
        u32x4 xr[2][4][2];
#pragma unroll
        for (int ai = 0; ai < 2; ++ai)
#pragma unroll
            for (int m = 0; m < 4; ++m) { const unsigned off = (unsigned)((tk[ai][m] < 0 ? 0 : tk[ai][m]) * D + col0);
#pragma unroll
                for (int bj = 0; bj < 2; ++bj) xr[ai][m][bj] = *(const u32x4*)(xi + off + bj * 128); }
#pragma unroll
        for (int ai = 0; ai < 2; ++ai)
#pragma unroll
            for (int m = 0; m < 4; ++m) { const int tok = tk[ai][m];
                if (tok >= 0) { const bool b1 = (tok >> 14) != 0; const unsigned off = (unsigned)(tok * D + col0);
#pragma unroll
                    for (int bj = 0; bj < 2; ++bj) { const u32x4 xw = xr[ai][m][bj]; const LAS float* gp = gate + (b1 ? 2048 : 0) + col0 + bj * 128; const f32x4 g0 = *(const LAS f32x4*)gp, g1 = *(const LAS f32x4*)(gp + 4);
                        const f32x4 x0 = {bflo(xw.x), bfhi(xw.x), bflo(xw.y), bfhi(xw.y)}, x1v = {bflo(xw.z), bfhi(xw.z), bflo(xw.w), bfhi(xw.w)};
                        const f32x4 o0 = x0 + g0 * acc[ai][bj][m][0], o1 = x1v + g1 * acc[ai][bj][m][1];
                        u32x4 w; w.x = pk2(o0[0], o0[1]); w.y = pk2(o0[2], o0[3]); w.z = pk2(o1[0], o1[1]); w.w = pk2(o1[2], o1[3]);
                        *(u32x4*)(xo + off + bj * 128) = w; } } }
    }
};

struct Args { const void* in[18]; float* out; unsigned char* ws; int ph_lo, ph_hi, li, pad; };
enum { I_X = 0, I_C, I_POS, I_WADA, I_BADA, I_N1W, I_N2W, I_WIN, I_WOUT, I_RNW, I_SGW, I_SGB, I_WR, I_RB, I_W1, I_W3, I_W2, I_FNW };

__device__ __forceinline__ const void* kargp(int idx) {
    int off = idx * 8; asm volatile("" : "+s"(off));
    typedef const void* cvp;
    const __attribute__((address_space(4))) char* k = (const __attribute__((address_space(4))) char*)__builtin_amdgcn_kernarg_segment_ptr();
    const cvp pp = *(const __attribute__((address_space(4))) cvp*)(k + off);
    return (const void*)(GAS const void*)pp;
}
struct Frame {
    LAS unsigned char* lds; int tid, lane, wave, G, vcu; unsigned char* ws;
};

__device__ __forceinline__ void transpose_item(const float* W, int ldw, int k0, int n0, bf16_t* dst, int ldd, LAS float* scr, int lane) {
#pragma unroll 8
    for (int i = 0; i < 32; ++i) { const int kk = 2 * i + (lane >> 5); scr[kk * 33 + (lane & 31)] = W[(size_t)(k0 + kk) * ldw + n0 + (lane & 31)]; }
    asm volatile("s_waitcnt lgkmcnt(0)" ::: "memory");
    const int c = lane & 7;
#pragma unroll
    for (int j = 0; j < 4; ++j) { const int n = (lane >> 3) + 8 * j; const LAS float* s = scr + (8 * c) * 33 + n;
        u32x4 o; o.x = pk2(s[0 * 33], s[1 * 33]); o.y = pk2(s[2 * 33], s[3 * 33]); o.z = pk2(s[4 * 33], s[5 * 33]); o.w = pk2(s[6 * 33], s[7 * 33]);
        *(u32x4*)(dst + (size_t)n * ldd + k0 + 8 * c) = o; }
    asm volatile("s_waitcnt lgkmcnt(0)" ::: "memory");
}
__device__ __forceinline__ void convert_weights(Frame& F, const Args& a, int layer) {
    LAS float* scr = (LAS float*)(F.lds + F.wave * 16384);
    LAS float* wmax = (LAS float*)(F.lds + KTS_OFF + 16384);
    const int gw = F.vcu * NWAVES + F.wave, NGW = F.G * NWAVES;
    const float* w_in = (const float*)kargp(I_WIN) + (size_t)layer * D * INC;
    const float* w_out = (const float*)kargp(I_WOUT) + (size_t)layer * D * D;
    const float* w1 = (const float*)kargp(I_W1) + (size_t)layer * NE * D * FF;
    const float* w3 = (const float*)kargp(I_W3) + (size_t)layer * NE * D * FF;
    const float* w2 = (const float*)kargp(I_W2) + (size_t)layer * NE * FF * D;
    signed char* win_q = (signed char*)(F.ws + WS_WIN); signed char* wout_q = (signed char*)(F.ws + WS_WOUT); signed char* w13_q = (signed char*)(F.ws + WS_W13); bf16_t* w2_t = (bf16_t*)(F.ws + WS_W2);
    float* wsc_in = (float*)(F.ws + WS_WSC_IN); float* wsc_13 = (float*)(F.ws + WS_WSC_13); float* wsc_out = (float*)(F.ws + WS_WSC_OUT);
    constexpr int Q_IN = INC / 32, Q_E = FF / 32, Q_OUT = D / 32, NQ = Q_IN + 2 * NE * Q_E + Q_OUT;
    const int c = F.lane & 31, hf = F.lane >> 5, w = F.wave;
    for (int it = F.vcu; it < NQ; it += F.G) {
        const float* W; int ldw, n0; signed char* dst; float* scale;
        if (it < Q_IN) { W = w_in; ldw = INC; n0 = it * 32; dst = win_q + (size_t)n0 * D; scale = wsc_in + n0; }
        else if (it >= Q_IN + 2 * NE * Q_E) { W = w_out; ldw = D; n0 = (it - Q_IN - 2 * NE * Q_E) * 32; dst = wout_q + (size_t)n0 * D; scale = wsc_out + n0; }
        else { int r = it - Q_IN; const int which = r / (NE * Q_E); r -= which * NE * Q_E; const int e = r / Q_E; n0 = (r - e * Q_E) * 32;
            const int drow = e * 1024 + (n0 >> 7) * 256 + which * 128 + (n0 & 127);
            W = (which ? w3 : w1) + (size_t)e * D * FF; ldw = FF; dst = w13_q + (size_t)drow * D; scale = wsc_13 + drow; }
        float v[4][32]; float am = 0.f;
        const float* wp = W + (size_t)(256 * w + hf) * ldw + n0 + c;
#pragma unroll
        for (int t = 0; t < 4; ++t)
#pragma unroll
            for (int i = 0; i < 32; ++i) v[t][i] = wp[(size_t)(64 * t + 2 * i) * ldw];
#pragma unroll
        for (int t = 0; t < 4; ++t)
#pragma unroll
            for (int i = 0; i < 32; ++i) am = fmaxf(am, fabsf(v[t][i]));
        am = fmaxf(am, __shfl_xor(am, 32));
        if (F.lane < 32) wmax[w * 32 + c] = am;
        __syncthreads();
        float cm = 1e-30f;
#pragma unroll
        for (int ww = 0; ww < 8; ++ww) cm = fmaxf(cm, wmax[ww * 32 + c]);
        const float inv = 127.0f / cm;
        if (w == 0 && F.lane < 32) scale[c] = cm * (1.0f / 127.0f);
#pragma unroll
        for (int t = 0; t < 4; ++t) {
#pragma unroll
            for (int i = 0; i < 32; ++i) scr[(2 * i + hf) * 33 + c] = v[t][i];
            asm volatile("s_waitcnt lgkmcnt(0)" ::: "memory");
            const LAS float* sp = scr + (32 * hf) * 33 + c;
            u32x4 o0, o1;
            o0.x = q4((f32x4){sp[0 * 33], sp[1 * 33], sp[2 * 33], sp[3 * 33]} * inv); o0.y = q4((f32x4){sp[4 * 33], sp[5 * 33], sp[6 * 33], sp[7 * 33]} * inv);
            o0.z = q4((f32x4){sp[8 * 33], sp[9 * 33], sp[10 * 33], sp[11 * 33]} * inv); o0.w = q4((f32x4){sp[12 * 33], sp[13 * 33], sp[14 * 33], sp[15 * 33]} * inv);
            o1.x = q4((f32x4){sp[16 * 33], sp[17 * 33], sp[18 * 33], sp[19 * 33]} * inv); o1.y = q4((f32x4){sp[20 * 33], sp[21 * 33], sp[22 * 33], sp[23 * 33]} * inv);
            o1.z = q4((f32x4){sp[24 * 33], sp[25 * 33], sp[26 * 33], sp[27 * 33]} * inv); o1.w = q4((f32x4){sp[28 * 33], sp[29 * 33], sp[30 * 33], sp[31 * 33]} * inv);
            signed char* dp = dst + (size_t)c * D + 256 * w + 64 * t + 32 * hf;
            *(u32x4*)dp = o0; *(u32x4*)(dp + 16) = o1;
            asm volatile("s_waitcnt lgkmcnt(0)" ::: "memory");
        }
        __syncthreads();
    }
    constexpr int I_E2 = (FF / 64) * (D / 32);
    constexpr int NIT = NE * I_E2;
    for (int it = gw; it < NIT; it += NGW) {
        int r = it;
        { const int e = r / I_E2; r -= e * I_E2; const int nb = D / 32, kb = r / nb, n0 = (r % nb) * 32;
            transpose_item(w2 + (size_t)e * FF * D, D, kb * 64, n0, w2_t + ((size_t)e * 2048 + n0) * FF, FF, scr, F.lane); }
    }
}
__device__ __forceinline__ void p0_prologue(Frame& F, const Args& a) {
    const int gt = F.vcu * NTHR + F.tid, NGT = F.G * NTHR;
    for (int step = 0; step < 2; ++step) {
    if ((step ^ (F.vcu & 1)) == 0) {
    { const int* pos = (const int*)kargp(I_POS); unsigned* rot = (unsigned*)(F.ws + WS_COS);
      for (int idx = gt; idx < NTOK * 128; idx += NGT) { const int tok = idx >> 7, j = idx & 127;
          const float inv = exp2f(-(float)j * (13.287712379549449f / 128.0f));
          const double rev = (double)pos[tok] * (double)inv * 0.15915494309189535; const float fr = (float)(rev - __builtin_rint(rev));
          rot[idx] = pk2(__builtin_amdgcn_cosf(fr), __builtin_amdgcn_sinf(fr)); } }
    { const float* wr = (const float*)kargp(I_WR); bf16_t* wrt = (bf16_t*)(F.ws + WS_WRT);
      for (int idx = gt; idx < NE * D; idx += NGT) { const int e = idx >> 11, k = idx & 2047; wrt[idx] = (bf16_t)f2bf(wr[k * NE + e]); }
      const float* sw = (const float*)kargp(I_SGW); bf16_t* swb = (bf16_t*)(F.ws + WS_SGW);
      for (int idx = gt; idx < 2 * SGG * CH * CH; idx += NGT) { const int m = idx & 127, n = (idx >> 7) & 127; swb[idx] = (m <= n) ? (bf16_t)f2bf(sw[idx]) : (bf16_t)0; } }
    } else {
    { LAS float* cact = (LAS float*)F.lds; LAS float* red = (LAS float*)(F.lds + 16384);
      const float* cc = (const float*)kargp(I_C);
      for (int i = F.tid; i < NB * D; i += NTHR) cact[i] = siluf_(cc[i]);
      __syncthreads();
      for (int cb = F.vcu; cb < 256; cb += F.G) {
          const int col0 = cb * 96, layer = col0 / 12288, cl0 = col0 - layer * 12288;
          const float* wa = (const float*)kargp(I_WADA) + (size_t)layer * D * 12288;
          if (F.tid < 504) { const int cg = F.tid % 24, kp = F.tid / 24; f32x4 s0 = {0.f, 0.f, 0.f, 0.f}, s1 = {0.f, 0.f, 0.f, 0.f};
              const int k0 = kp * 98, k1 = k0 + 98 < D ? k0 + 98 : D;
#pragma unroll 14
              for (int k = k0; k < k1; ++k) { const f32x4 w = *(const f32x4*)(wa + (size_t)k * 12288 + cl0 + 4 * cg); s0 += w * cact[k]; s1 += w * cact[D + k]; }
              *(LAS f32x4*)(red + ((kp * 24 + cg) * 2 + 0) * 4) = s0; *(LAS f32x4*)(red + ((kp * 24 + cg) * 2 + 1) * 4) = s1; }
          __syncthreads();
          if (F.tid < 192) { const int i = F.tid & 3, b = (F.tid >> 2) & 1, cg = F.tid >> 3; float s = 0.f;
#pragma unroll
              for (int kp = 0; kp < 21; ++kp) s += red[((kp * 24 + cg) * 2 + b) * 4 + i];
              const int cl = cl0 + 4 * cg + i; s += ((const float*)kargp(I_BADA))[layer * 12288 + cl];
              ((float*)(F.ws + WS_MOD))[(size_t)(layer * 2 + b) * 12288 + cl] = s; }
          __syncthreads();
      } }
    }
    }
}

template <bool FINAL, bool IN_F32>
__device__ __forceinline__ void p_norm(Frame& F, const void* x, const float* w, const float* modl  , int shift_off, int scale_off, signed char* outb, float* hsc, float* outf, bf16_t* xcopy = nullptr) {
    const int gw = F.vcu * NWAVES + F.wave, NGW = F.G * NWAVES;
    f32x4 nf[8]; u32x2 nh[8];
#define NORM_LOAD(r_) do { if (IN_F32) { const f32x4* xr_ = (const f32x4*)((const float*)x + (size_t)(r_) * D) + F.lane; _Pragma("unroll") for (int j = 0; j < 8; ++j) nf[j] = xr_[64 * j]; } \
        else { const u32x2* xr_ = (const u32x2*)((const bf16_t*)x + (size_t)(r_) * D) + F.lane; _Pragma("unroll") for (int j = 0; j < 8; ++j) nh[j] = xr_[64 * j]; } } while (0)
    if (gw < NTOK) NORM_LOAD(gw);
    for (int row = gw; row < NTOK; row += NGW) {
        f32x4 v[8]; float s = 0.f;
        if (IN_F32) {
#pragma unroll
            for (int j = 0; j < 8; ++j) v[j] = nf[j]; }
        else {
#pragma unroll
            for (int j = 0; j < 8; ++j) { const u32x2 xw = nh[j]; v[j] = (f32x4){bflo(xw.x), bfhi(xw.x), bflo(xw.y), bfhi(xw.y)}; } }
        if (row + NGW < NTOK) NORM_LOAD(row + NGW);
        if (IN_F32 && !FINAL) { if (xcopy != nullptr) {
#pragma unroll
            for (int j = 0; j < 8; ++j) { u32x2 cw; cw.x = pk2(v[j][0], v[j][1]); cw.y = pk2(v[j][2], v[j][3]); *((u32x2*)(xcopy + (size_t)row * D) + 64 * j + F.lane) = cw; } } }
#pragma unroll
        for (int j = 0; j < 8; ++j) s += (v[j][0] * v[j][0] + v[j][1] * v[j][1]) + (v[j][2] * v[j][2] + v[j][3] * v[j][3]);
        const float rstd = 1.0f / sqrtf(wave_sum(s) * (1.0f / D) + EPS);
        if (FINAL) {
#pragma unroll
            for (int j = 0; j < 8; ++j) { const f32x4 wv = *((const f32x4*)w + 64 * j + F.lane); *((f32x4*)(outf + (size_t)row * D) + 64 * j + F.lane) = v[j] * rstd * wv; }
        } else {
            const float* mb = modl + (size_t)(row >> 14) * 12288; float am = 0.f;
#pragma unroll
            for (int j = 0; j < 8; ++j) { const f32x4 wv = *((const f32x4*)w + 64 * j + F.lane), sc = *((const f32x4*)(mb + scale_off) + 64 * j + F.lane), sh = *((const f32x4*)(mb + shift_off) + 64 * j + F.lane);
                v[j] = v[j] * rstd * wv * (sc + 1.0f) + sh;
                am = fmaxf(am, fmaxf(fmaxf(fabsf(v[j][0]), fabsf(v[j][1])), fmaxf(fabsf(v[j][2]), fabsf(v[j][3])))); }
#pragma unroll
            for (int o = 1; o < 64; o <<= 1) am = fmaxf(am, __shfl_xor(am, o));
            am = fmaxf(am, 1e-20f); const float inv = 127.0f / am;
            if (F.lane == 0) hsc[row] = am * (1.0f / 127.0f);
#pragma unroll
            for (int j = 0; j < 8; ++j) { *((unsigned*)(outb + (size_t)row * D) + 64 * j + F.lane) = q4(v[j] * inv); }
        }
    }
}

#undef NORM_LOAD
__device__ __forceinline__ void p_scan(Frame& F) {
    const int gt = F.vcu * NTHR + F.tid;
    if (gt >= 8 * 256 * 32) return;
    const int bh = gt >> 13, rem = gt & 8191, h = bh & 3;
    const float cd = exp2f(log2_gamma(h) * 128.0f);
    u32x2* p = (u32x2*)(F.ws + WS_KVT + (size_t)bh * 128 * 65536 + (size_t)rem * 8);
    f32x4 s0 = {0.f, 0.f, 0.f, 0.f}, s1 = {0.f, 0.f, 0.f, 0.f};
    for (int c0 = 0; c0 < NCH; c0 += 8) {
        u32x2 kv[8];
#pragma unroll
        for (int i = 0; i < 8; ++i) kv[i] = p[(size_t)(c0 + i) * (65536 / 8)];
#pragma unroll
        for (int i = 0; i < 8; ++i) { p[(size_t)(c0 + i) * (65536 / 8)] = f8pack(s0, s1);
            f32x4 k0, k1; f8unpack(kv[i], k0, k1); s0 = s0 * cd + k0; s1 = s1 * cd + k1; }
    }
}

template <bool WIDE> __device__ __forceinline__ void piece_load(u32x4 (&r)[4], const bf16_t* base, size_t gpitch, int tid) {
    const bf16_t* p0 = base + (size_t)(WIDE ? tid >> 5 : tid >> 4) * gpitch + (WIDE ? tid & 31 : tid & 15) * 8;
#pragma unroll
    for (int i = 0; i < 4; ++i) r[i] = *(const u32x4*)(p0 + (size_t)(WIDE ? 16 : 32) * i * gpitch);
}
__device__ __forceinline__ void piece_load8(u32x4 (&r)[4], const unsigned char* base, int tid) {
    const unsigned char* p0 = base + (tid >> 5) * 256 + (tid & 31) * 8;
#pragma unroll
    for (int i = 0; i < 4; ++i) { const u32x2 v = *(const u32x2*)(p0 + 16 * i * 256); r[i].x = v.x; r[i].y = v.y; }
}
__device__ __forceinline__ void piece_cvt8(u32x4 (&r)[4]) {
#pragma unroll
    for (int i = 0; i < 4; ++i) { f32x4 a, b; u32x2 v; v.x = r[i].x; v.y = r[i].y; f8unpack(v, a, b);
        r[i].x = pk2(a[0], a[1]); r[i].y = pk2(a[2], a[3]); r[i].z = pk2(b[0], b[1]); r[i].w = pk2(b[2], b[3]); }
}
__device__ __forceinline__ void piece_store(LAS unsigned char* buf, int st0, const u32x4 (&r)[4]) {
#pragma unroll
    for (int i = 0; i < 4; ++i) *(LAS u32x4*)(buf + st0 + 8192 * i) = r[i];
}
__device__ __forceinline__ void p_retsg(Frame& F, const Args& a, int layer) {
    const bf16_t* Q = (const bf16_t*)(F.ws + WS_Q); const bf16_t* Kk = (const bf16_t*)(F.ws + WS_K); const bf16_t* Gg = (const bf16_t*)(F.ws + WS_G); const bf16_t* Uu = (const bf16_t*)(F.ws + WS_U);
    const bf16_t* VT = (const bf16_t*)(F.ws + WS_VT); const bf16_t* VST = (const bf16_t*)(F.ws + WS_VST); const unsigned char* ST = (const unsigned char*)(F.ws + WS_KVT);
    bf16_t* MIX = (bf16_t*)(F.ws + WS_HBUF);
    const float* rnw = (const float*)kargp(I_RNW) + (size_t)layer * RW;
    const int tid = F.tid; const int l16 = tid & 15, g = (tid >> 4) & 3, w = __builtin_amdgcn_readfirstlane(tid >> 6);
    LAS unsigned char* buf0 = F.lds; LAS unsigned char* buf1 = F.lds + 32768;
    int swW[8];
    const int ldsb = (int)(unsigned)(size_t)F.lds;
#pragma unroll
    for (int s = 0; s < 8; ++s) { swW[s] = ldsb + ((l16 * 32 + ((4 * s + g) ^ l16)) << 4); asm volatile("" : "+v"(swW[s])); }
#define LRD128(dst, addr, off) asm volatile("ds_read_b128 %0, %1 offset:%2" : "=v"(dst) : "v"(addr), "n"(off) : "memory")
#define LWAIT4(q) asm volatile("s_waitcnt lgkmcnt(0)" : "+v"((q)[0]), "+v"((q)[1]), "+v"((q)[2]), "+v"((q)[3]) :: "memory")
#define BO(p) (((p) % 3) * 32768)
#define AW(s, p) (((p) % 3) == 2 ? swW[(s)] + 65536 : swW[(s)])
#define OFFB(p) (((p) % 3) == 2 ? 0 : ((p) % 3) * 32768)
#define RD4_W(q, pp, rt, s0) do { LRD128((q)[0], AW((s0), pp), OFFB(pp) + (rt) * 8192); LRD128((q)[1], AW((s0) + 1, pp), OFFB(pp) + (rt) * 8192); LRD128((q)[2], AW((s0) + 2, pp), OFFB(pp) + (rt) * 8192); LRD128((q)[3], AW((s0) + 3, pp), OFFB(pp) + (rt) * 8192); } while (0)
#define WAITV(n) asm volatile("s_waitcnt vmcnt(" #n ")" ::: "memory")
#define LBAR() asm volatile("s_waitcnt lgkmcnt(0)\n\ts_barrier" ::: "memory")
    const unsigned ldsw = (unsigned)__builtin_amdgcn_readfirstlane(w) * 1024u;
#define DV_S ((unsigned)(tid >> 4) * 256u + (unsigned)(tid & 15) * 16u)
#define DV_W ((unsigned)(tid >> 5) * 2048u + (unsigned)((tid & 31) ^ ((tid >> 5) & 15)) * 16u)
#define DV_N ((unsigned)(tid >> 4) * 256u + (unsigned)((tid & 15) ^ ((tid >> 4) & 15)) * 16u)
#define CV_S ((((((tid >> 4) & 15) * 32) + ((2 * (tid & 15)) ^ ((tid >> 4) & 15))) << 4) + (tid >> 8) * 8192)
#define RET_DMA_STATE(sbase, qq) do { const char* gb_ = (const char*)(sbase) + (size_t)(64 * (qq)) * 256; unsigned o_ = DV_S; asm volatile("" : "+v"(o_));   _Pragma("unroll") for (int j_ = 0; j_ < 2; ++j_) \
        __builtin_amdgcn_global_load_lds((const unsigned*)(gb_ + (o_ + 8192u * (unsigned)j_)), (LAS unsigned*)(F.lds + 98304 + ((qq) & 1) * 16384 + j_ * 8192 + ldsw), 16, 0, 0); } while (0)
#define RET_DMA_WIDE(kbase, kq, pp) do { const char* gb_ = (const char*)((kbase) + (size_t)(64 * (kq)) * 1024); unsigned o_ = DV_W; asm volatile("" : "+v"(o_)); _Pragma("unroll") for (int i_ = 0; i_ < 4; ++i_) \
        __builtin_amdgcn_global_load_lds((const unsigned*)(gb_ + (o_ + 32768u * (unsigned)i_)), (LAS unsigned*)(F.lds + BO(pp) + i_ * 8192 + ldsw), 16, 0, 0); } while (0)
#define RET_DMA_NARROW(vbase, vq, pp) do { const char* gb_ = (const char*)((vbase) + (size_t)(128 * (vq)) * 128); unsigned o_ = DV_N; asm volatile("" : "+v"(o_)); _Pragma("unroll") for (int i_ = 0; i_ < 4; ++i_) \
        __builtin_amdgcn_global_load_lds((const unsigned*)(gb_ + (o_ + 8192u * (unsigned)i_)), (LAS unsigned*)(F.lds + BO(pp) + i_ * 8192 + ldsw), 16, 0, 0); } while (0)
#define RD4_N(q, bo, rt) do { LRD128((q)[0], swN[0], (bo) + (rt) * 4096); LRD128((q)[1], swN[1], (bo) + (rt) * 4096); LRD128((q)[2], swN[2], (bo) + (rt) * 4096); LRD128((q)[3], swN[3], (bo) + (rt) * 4096); } while (0)
    LAS float* rr = (LAS float*)(F.lds + 65536);
    if (F.vcu < 256) { const int U = F.vcu;
    float rowam = 0.f;
    bf16x8 qf[8];
    {   const bf16_t* qrow = Q + (size_t)((U >> 7) * SEQ + (U & 127) * CH + 16 * w + l16) * 1024 + 8 * g;
#pragma unroll
        for (int s = 0; s < 8; ++s) qf[s] = *(const bf16x8*)(qrow + 32 * s); }
    for (int h = 0; h < RH; ++h) {
        const int ch = U & 127, b = U >> 7, L = b * 512 + h * 128 + ch;
        const int T0 = b * SEQ + ch * CH;
        const float lg = log2_gamma(h);
        const int nloc = 16 * w + l16;
        u32x2 gwp[16];
        f32x4 acc[16];
#pragma unroll
        for (int et = 0; et < 16; ++et) acc[et] = (f32x4){0.f, 0.f, 0.f, 0.f};
        unsigned pt[8][2];
        const unsigned char* stb = ST + (size_t)L * 65536; const bf16_t* kb = Kk + (size_t)T0 * 1024 + h * 256; const bf16_t* vb = VT + ((size_t)(T0 >> 7) * 1024 + (size_t)(h * 256)) * 128;
        const unsigned char* stbn = stb + (size_t)128 * 65536;
        if (h == 0) { RET_DMA_STATE(stb, 0); RET_DMA_STATE(stb, 1); }
        LBAR();
#pragma unroll
        for (int p = 0; p < 8; ++p) {
            LAS unsigned char* buf = F.lds + BO(p);
            if (p == 0) { if (h == 0) WAITV(2); else WAITV(16); } else if (p < 3) WAITV(2); else if (p < 7) WAITV(4); else { if (h + 1 < RH) WAITV(26); else WAITV(16); }
            if (p < 4) {
                const LAS unsigned char* rawp = F.lds + 98304 + (p & 1) * 16384 + tid * 16;
                int cvS = CV_S; asm volatile("" : "+v"(cvS));
                LAS unsigned char* db = F.lds + BO(p) + cvS;
#pragma unroll
                for (int j = 0; j < 2; ++j) { const u32x4 rv = *(const LAS u32x4*)(rawp + j * 8192);
                    f32x4 a, b2; u32x2 v; u32x4 o;
                    v.x = rv.x; v.y = rv.y; f8unpack(v, a, b2); o.x = pk2(a[0], a[1]); o.y = pk2(a[2], a[3]); o.z = pk2(b2[0], b2[1]); o.w = pk2(b2[2], b2[3]);
                    *(LAS u32x4*)(db + j * 16384) = o;
                    v.x = rv.z; v.y = rv.w; f8unpack(v, a, b2); o.x = pk2(a[0], a[1]); o.y = pk2(a[2], a[3]); o.z = pk2(b2[0], b2[1]); o.w = pk2(b2[2], b2[3]);
                    *(LAS u32x4*)(F.lds + BO(p) + (cvS ^ 16) + j * 16384) = o; }
            }
            LBAR();
            if (p + 2 < 4) RET_DMA_STATE(stb, p + 2);
            else if (p + 2 < 6) RET_DMA_WIDE(kb, p + 2 - 4, p + 2);
            else if (p + 2 < 8) RET_DMA_NARROW(vb, p + 2 - 6, p + 2);
            else if (h + 1 < RH) RET_DMA_STATE(stbn, p + 2 - 8);
            if (p == 6) {
                if (h + 1 < RH) { const bf16_t* qrow = Q + (size_t)(T0 + nloc) * 1024 + (h + 1) * 256 + 8 * g;
#pragma unroll
                    for (int s = 0; s < 8; ++s) qf[s] = *(const bf16x8*)(qrow + 32 * s); }
#pragma unroll
                for (int et = 0; et < 16; ++et) gwp[et] = *(const u32x2*)(Gg + (size_t)(T0 + nloc) * 1024 + h * 256 + 16 * et + 4 * g);
            }
            if (p < 4) {
                {   bf16x8 fq[2][4];
                    RD4_W(fq[0], p, 0, 0);
#pragma unroll
                    for (int k = 0; k < 8; ++k) {
                        LWAIT4(fq[k & 1]);
                        if (k + 1 < 8) RD4_W(fq[(k + 1) & 1], p, (k + 1) >> 1, 4 * ((k + 1) & 1));
#pragma unroll
                        for (int j = 0; j < 4; ++j) acc[4 * p + (k >> 1)] = __builtin_amdgcn_mfma_f32_16x16x32_bf16(fq[k & 1][j], qf[4 * (k & 1) + j], acc[4 * p + (k >> 1)], 0, 0, 0);
                    } }
                if (p == 3) { const float qd = __builtin_amdgcn_exp2f(lg * (float)(nloc + 1));
#pragma unroll
                    for (int et = 0; et < 16; ++et) acc[et] *= qd; }
            } else if (p < 6) {
                if (p == 4) {
#pragma unroll
                    for (int t = 0; t < 8; ++t) { pt[t][0] = 0u; pt[t][1] = 0u; } }
#pragma unroll
                for (int ml = 0; ml < 4; ++ml) { const int t = 4 * (p - 4) + ml;
                    if (t <= w) { f32x4 sc = {0.f, 0.f, 0.f, 0.f};
                        bf16x8 fa[2][2];
                        LRD128(fa[0][0], AW(0, p), OFFB(p) + ml * 8192); LRD128(fa[0][1], AW(1, p), OFFB(p) + ml * 8192);
#pragma unroll
                        for (int k = 0; k < 4; ++k) {
                            asm volatile("s_waitcnt lgkmcnt(0)" : "+v"(fa[k & 1][0]), "+v"(fa[k & 1][1]) :: "memory");
                            if (k + 1 < 4) { LRD128(fa[(k + 1) & 1][0], AW(2 * (k + 1), p), OFFB(p) + ml * 8192); LRD128(fa[(k + 1) & 1][1], AW(2 * (k + 1) + 1, p), OFFB(p) + ml * 8192); }
                            sc = __builtin_amdgcn_mfma_f32_16x16x32_bf16(fa[k & 1][0], qf[2 * k], sc, 0, 0, 0);
                            sc = __builtin_amdgcn_mfma_f32_16x16x32_bf16(fa[k & 1][1], qf[2 * k + 1], sc, 0, 0, 0);
                        }
                        float pv[4];
#pragma unroll
                        for (int r = 0; r < 4; ++r) { const int df = nloc - (16 * t + 4 * g + r); pv[r] = df >= 0 ? sc[r] * __builtin_amdgcn_exp2f(lg * (float)df) : 0.f; }
                        pt[t][0] = pk2(pv[0], pv[1]); pt[t][1] = pk2(pv[2], pv[3]); }
                    asm volatile("" ::: "memory"); }
            } else {
#pragma unroll
                for (int u = 0; u < 4; ++u) {
                    if (2 * u <= w) { u32x4 bw; bw.x = pt[2 * u][0]; bw.y = pt[2 * u][1]; bw.z = pt[2 * u + 1][0]; bw.w = pt[2 * u + 1][1];
                        const bf16x8 bf = __builtin_bit_cast(bf16x8, bw);
                        const int sP0 = ((l16 * 16 + ((4 * u + (g >> 1)) ^ l16)) << 4) + 8 * (g & 1), sP1 = ((l16 * 16 + ((4 * u + 2 + (g >> 1)) ^ l16)) << 4) + 8 * (g & 1);
#pragma unroll
                        for (int el = 0; el < 8; ++el) { const u32x2 lo = *(const LAS u32x2*)(buf + sP0 + el * 4096), hi = *(const LAS u32x2*)(buf + sP1 + el * 4096);
                            u32x4 aw; aw.x = lo.x; aw.y = lo.y; aw.z = hi.x; aw.w = hi.y;
                            acc[8 * (p - 6) + el] = __builtin_amdgcn_mfma_f32_16x16x32_bf16(__builtin_bit_cast(bf16x8, aw), bf, acc[8 * (p - 6) + el], 0, 0, 0); }
                        asm volatile("" ::: "memory"); } }
            }
        }
        float ss = 0.f;
#pragma unroll
        for (int et = 0; et < 16; ++et) ss += (acc[et][0] * acc[et][0] + acc[et][1] * acc[et][1]) + (acc[et][2] * acc[et][2] + acc[et][3] * acc[et][3]);
        ss += __shfl_xor(ss, 16); ss += __shfl_xor(ss, 32);
        const float rstd = 1.0f / sqrtf(ss * (1.0f / RD) + EPS);
        const size_t tokoff = (size_t)(T0 + nloc);
        float am = 0.f;
#pragma unroll
        for (int et = 0; et < 16; ++et) { const int e = h * 256 + 16 * et + 4 * g;
            const f32x4 wv = *(const f32x4*)(rnw + e); const u32x2 gw = gwp[et];
            const float o0 = acc[et][0] * rstd * wv[0] * bflo(gw.x), o1 = acc[et][1] * rstd * wv[1] * bfhi(gw.x), o2 = acc[et][2] * rstd * wv[2] * bflo(gw.y), o3 = acc[et][3] * rstd * wv[3] * bfhi(gw.y);
            am = fmaxf(am, fmaxf(fmaxf(fabsf(o0), fabsf(o1)), fmaxf(fabsf(o2), fabsf(o3))));
            u32x2 ow; ow.x = pk2(o0, o1); ow.y = pk2(o2, o3);
            *(u32x2*)(MIX + tokoff * D + e) = ow; }
        am = fmaxf(am, __shfl_xor(am, 16)); am = fmaxf(am, __shfl_xor(am, 32)); rowam = fmaxf(rowam, am);
    }
    {
        const int L = U;
        const int ch = L & 127, b = L >> 7; const int T0 = b * SEQ + ch * CH;
        const bf16_t* swb = (const bf16_t*)(F.ws + WS_SGW) + (size_t)layer * SGG * CH * CH;
        const float* sgb = (const float*)kargp(I_SGB) + (size_t)layer * SGG * CH;
        const bf16_t* vsb = VST + (size_t)(T0 >> 7) * 1024 * 128;
        u32x4 rg[4];
        int tidS = tid; asm volatile("" : "+v"(tidS));
        piece_load<false>(rg, vsb, 128, tidS);
        int gS = g; asm volatile("" : "+v"(gS));
        int swN[4]; const int l16S = tidS & 15;
#pragma unroll
        for (int s = 0; s < 4; ++s) { swN[s] = ldsb + ((l16S * 16 + ((4 * s + gS) ^ l16S)) << 4); asm volatile("" : "+v"(swN[s])); }
        int stN = ((((tidS >> 4) * 16) + ((tidS & 15) ^ ((tidS >> 4) & 15))) << 4); asm volatile("" : "+v"(stN));
        int nloc = 16 * w + l16; asm volatile("" : "+v"(nloc));
        const size_t tokoff = (size_t)(T0 + nloc);
#define SG_LOAD(gq) do { _Pragma("unroll") for (int s = 0; s < 4; ++s) wn[s] = *(const u32x4*)(swb + ((size_t)(gq) * CH + nloc) * CH + 32 * s + 8 * gS);     \
        _Pragma("unroll") for (int dt = 0; dt < 8; ++dt) un[dt] = *(const u32x2*)(Uu + tokoff * 1024 + (gq) * 128 + 16 * dt + 4 * gS); bn = sgb[(gq) * CH + nloc]; } while (0)
        u32x4 wn[4]; u32x2 un[8]; float bn;
        SG_LOAD(0);
        float lam = 0.f;
        __syncthreads();
#pragma unroll
        for (int gi = 0; gi < SGG; ++gi) {
            LAS unsigned char* buf = (gi & 1) ? buf1 : buf0;
            piece_store(buf, stN, rg);
            u32x4 wcur[4]; u32x2 ucur[8];
#pragma unroll
            for (int s = 0; s < 4; ++s) wcur[s] = wn[s];
#pragma unroll
            for (int dt = 0; dt < 8; ++dt) ucur[dt] = un[dt];
            const float bias = bn;
            __syncthreads();
            if (gi + 1 < SGG) { piece_load<false>(rg, vsb + (size_t)((gi + 1) * 128) * 128, 128, tidS); SG_LOAD(gi + 1); }
            {
                const int tk = tid & 127, qt = tid >> 7; float sq = 0.f;
#pragma unroll 8
                for (int d = 32 * qt; d < 32 * qt + 32; ++d) { const bf16_t v = *(const LAS bf16_t*)(buf + ((d * 16 + ((tk >> 3) ^ (d & 15))) << 4) + 2 * (tk & 7)); const float f = __builtin_bit_cast(float, ((unsigned)v) << 16); sq += f * f; }
                rr[512 + qt * 128 + tk] = sq;
            }
            __syncthreads();
            if (tid < 128) rr[tid] = 1.0f / sqrtf((rr[512 + tid] + rr[640 + tid] + rr[768 + tid] + rr[896 + tid]) * (1.0f / SGD) + EPS);
            __syncthreads();
            bf16x8 bfr[4];
#pragma unroll
            for (int s = 0; s < 4; ++s) {
                u32x4 ww;
                {
                    const u32x4 wv = wcur[s];
                    const f32x4 r0 = *(const LAS f32x4*)(rr + 32 * s + 8 * g), r1 = *(const LAS f32x4*)(rr + 32 * s + 8 * g + 4);
                    ww.x = pk2(bflo(wv.x) * r0[0], bfhi(wv.x) * r0[1]); ww.y = pk2(bflo(wv.y) * r0[2], bfhi(wv.y) * r0[3]);
                    ww.z = pk2(bflo(wv.z) * r1[0], bfhi(wv.z) * r1[1]); ww.w = pk2(bflo(wv.w) * r1[2], bfhi(wv.w) * r1[3]);
                }
                bfr[s] = __builtin_bit_cast(bf16x8, ww);
            }
            bf16x8 fz[2][4];
            if (gi & 1) RD4_N(fz[0], 32768, 0); else RD4_N(fz[0], 0, 0);
#pragma unroll
            for (int dt = 0; dt < 8; ++dt) {
                f32x4 z = {0.f, 0.f, 0.f, 0.f};
                LWAIT4(fz[dt & 1]);
                if (dt + 1 < 8) { if (gi & 1) RD4_N(fz[(dt + 1) & 1], 32768, dt + 1); else RD4_N(fz[(dt + 1) & 1], 0, dt + 1); }
#pragma unroll
                for (int s = 0; s < 4; ++s) z = __builtin_amdgcn_mfma_f32_16x16x32_bf16(fz[dt & 1][s], bfr[s], z, 0, 0, 0);
                const int d = gi * 128 + 16 * dt + 4 * gS;
                const u32x2 uw = ucur[dt];
                const float o0 = bflo(uw.x) * (z[0] + bias), o1 = bfhi(uw.x) * (z[1] + bias), o2 = bflo(uw.y) * (z[2] + bias), o3 = bfhi(uw.y) * (z[3] + bias);
                lam = fmaxf(lam, fmaxf(fmaxf(fabsf(o0), fabsf(o1)), fmaxf(fabsf(o2), fabsf(o3))));
                u32x2 ow; ow.x = pk2(o0, o1); ow.y = pk2(o2, o3);
                *(u32x2*)(MIX + tokoff * D + 1024 + d) = ow;
            }
        }
#undef SG_LOAD
        lam = fmaxf(lam, __shfl_xor(lam, 16)); lam = fmaxf(lam, __shfl_xor(lam, 32)); rowam = fmaxf(rowam, lam);
        asm volatile("s_waitcnt vmcnt(0)" ::: "memory");
        signed char* MIXQ = (signed char*)(F.ws + WS_MIXQ); float* msc = (float*)(F.ws + WS_HSC);
#define QLOAD(dst, tq) do { _Pragma("unroll") for (int tt = 0; tt < 2; ++tt) { const int tok_ = T0 + 16 * w + 2 * (tq) + tt; \
            _Pragma("unroll") for (int i = 0; i < 4; ++i) dst[tt][i] = *((const u32x4*)(MIX + (size_t)tok_ * D) + 64 * i + F.lane); } } while (0)
        u32x4 rv[2][4];
        QLOAD(rv, 0);
#pragma unroll
        for (int t2 = 0; t2 < 8; ++t2) {
            u32x4 rn[2][4]; float inv[2];
            if (t2 + 1 < 8) QLOAD(rn, t2 + 1);
#pragma unroll
            for (int tt = 0; tt < 2; ++tt) { const float a_ = fmaxf(__shfl(rowam, 2 * t2 + tt), 1e-20f); inv[tt] = 127.0f / a_;
                if (F.lane == 0) msc[T0 + 16 * w + 2 * t2 + tt] = a_ * (1.0f / 127.0f); }
#pragma unroll
            for (int tt = 0; tt < 2; ++tt) { const int tok = T0 + 16 * w + 2 * t2 + tt;
#pragma unroll
                for (int i = 0; i < 4; ++i) { const u32x4 v = rv[tt][i]; u32x2 q;
                    q.x = q4((f32x4){bflo(v.x), bfhi(v.x), bflo(v.y), bfhi(v.y)} * inv[tt]); q.y = q4((f32x4){bflo(v.z), bfhi(v.z), bflo(v.w), bfhi(v.w)} * inv[tt]);
                    *((u32x2*)(MIXQ + (size_t)tok * D) + 64 * i + F.lane) = q; } }
#pragma unroll
            for (int tt = 0; tt < 2; ++tt)
#pragma unroll
                for (int i = 0; i < 4; ++i) rv[tt][i] = rn[tt][i];
        }
#undef QLOAD
    }
    }
    __syncthreads();
#undef DV_S
#undef DV_W
#undef DV_N
#undef CV_S
#undef BO
#undef AW
#undef OFFB
#undef WAITV
#undef LBAR
#undef RET_DMA_STATE
#undef RET_DMA_WIDE
#undef RET_DMA_NARROW
#undef LRD128
#undef LWAIT4
#undef RD4_W
#undef RD4_N
}

__device__ __forceinline__ void p_rbias(Frame& F, int layer) {
    if (F.vcu >= NB) return;
    const int b = F.vcu; LAS float* rbp = (LAS float*)(F.lds + 12288);
    const float* mb = (const float*)(F.ws + WS_MOD) + (size_t)(layer * 2 + b) * 12288 + 6144; const float* wr = (const float*)kargp(I_WR);
    const int e = F.tid & 31, part = F.tid >> 5; float s0 = 0.f, s1 = 0.f, s2 = 0.f, s3 = 0.f;
#pragma unroll 4
    for (int k = part * 128; k < part * 128 + 128; k += 4) { s0 += mb[k] * wr[k * NE + e]; s1 += mb[k + 1] * wr[(k + 1) * NE + e]; s2 += mb[k + 2] * wr[(k + 2) * NE + e]; s3 += mb[k + 3] * wr[(k + 3) * NE + e]; }
    rbp[part * 32 + e] = (s0 + s1) + (s2 + s3);
    __syncthreads();
    if (F.tid < 32) { float s = 0.f;
#pragma unroll
        for (int q = 0; q < 16; ++q) s += rbp[q * 32 + F.tid];
        ((float*)(F.ws + WS_RBW))[(layer * 2 + b) * 32 + F.tid] = s; }
}
__device__ __forceinline__ void p_router(Frame& F, const Args& a, int layer, const bf16_t* x1) {
    LAS float* cs = (LAS float*)F.lds;
    LAS float* sh = cs + 2048;
    LAS float* plog = sh + 2048;
    LAS float* red = plog + 4096;
    LAS float* rstdl = red + 128;
    LAS float* rb = rstdl + 16;
    LAS float* scl = rb + 32;
    LAS float* bsl = scl + 512;
    LAS unsigned* cnt = (LAS unsigned*)(bsl + 512);
    LAS unsigned* basel = cnt + 48;
    LAS int* tokb = (LAS int*)(basel + 48);
    LAS int* tokr = tokb + 128;
    LAS float* amaxl = (LAS float*)(tokr + 128);
    LAS float* gll = amaxl + 128;
    LAS float* scll = gll + 256;
    const float* modl = (const float*)(F.ws + WS_MOD) + (size_t)layer * 2 * 12288;
    const float* n2w = (const float*)kargp(I_N2W) + (size_t)layer * D;
    const float* rbias = (const float*)kargp(I_RB);
    const bf16_t* wrt = (const bf16_t*)(F.ws + WS_WRT);
    signed char* H2 = (signed char*)(F.ws + WS_HBUF); float* hsc = (float*)(F.ws + WS_HSC);
    unsigned* gcnt = (unsigned*)(F.ws + WS_CTL) + CW_CNT + layer * 64;
    const int l16 = F.lane & 15, g = F.lane >> 4, w = F.wave;
    bf16x8 bfr[8][2];
#pragma unroll
    for (int s = 0; s < 8; ++s)
#pragma unroll
        for (int et = 0; et < 2; ++et) bfr[s][et] = *(const bf16x8*)(wrt + (size_t)(16 * et + l16) * D + 256 * w + 32 * s + 8 * g);
    for (int wgp = F.vcu; wgp < NTOK / 128; wgp += F.G) {
        const int tok0 = wgp * 128, b = tok0 >> 14; const float* mb = modl + (size_t)b * 12288;
        const bf16_t* xbase = x1 + (size_t)(tok0 + l16) * D + 256 * w + 8 * g;
        u32x4 xnext[8];
#pragma unroll
        for (int s = 0; s < 8; ++s) xnext[s] = *(const u32x4*)(xbase + 32 * s);
        __syncthreads();
        for (int i = F.tid; i < D; i += NTHR) { cs[i] = n2w[i] * (1.0f + mb[8192 + i]); sh[i] = mb[6144 + i]; }
        if (F.tid < 48) cnt[F.tid] = 0u;
        if (F.tid < 32) rb[F.tid] = ((const float*)(F.ws + WS_RBW))[(layer * 2 + b) * 32 + F.tid];
        __syncthreads();
        for (int ti = 0; ti < 8; ++ti) {
            const int r0 = tok0 + 16 * ti;
            f32x4 xv[8][2];
#pragma unroll
            for (int s = 0; s < 8; ++s) { xv[s][0] = (f32x4){bflo(xnext[s].x), bfhi(xnext[s].x), bflo(xnext[s].y), bfhi(xnext[s].y)}; xv[s][1] = (f32x4){bflo(xnext[s].z), bfhi(xnext[s].z), bflo(xnext[s].w), bfhi(xnext[s].w)}; }
            if (ti + 1 < 8) {
#pragma unroll
                for (int s = 0; s < 8; ++s) xnext[s] = *(const u32x4*)(xbase + (size_t)(16 * (ti + 1)) * D + 32 * s); }
            float ssq = 0.f; f32x4 lacc[2] = {{0.f, 0.f, 0.f, 0.f}, {0.f, 0.f, 0.f, 0.f}};
#pragma unroll
            for (int s = 0; s < 8; ++s) {
                const f32x4 c0 = *(const LAS f32x4*)(cs + 256 * w + 32 * s + 8 * g), c1 = *(const LAS f32x4*)(cs + 256 * w + 32 * s + 8 * g + 4);
                const f32x4 a0 = xv[s][0], a1 = xv[s][1];
                ssq += (a0[0] * a0[0] + a0[1] * a0[1]) + (a0[2] * a0[2] + a0[3] * a0[3]) + (a1[0] * a1[0] + a1[1] * a1[1]) + (a1[2] * a1[2] + a1[3] * a1[3]);
                const f32x4 y0 = a0 * c0, y1 = a1 * c1;
                u32x4 aw; aw.x = pk2(y0[0], y0[1]); aw.y = pk2(y0[2], y0[3]); aw.z = pk2(y1[0], y1[1]); aw.w = pk2(y1[2], y1[3]);
                const bf16x8 af = __builtin_bit_cast(bf16x8, aw);
                lacc[0] = __builtin_amdgcn_mfma_f32_16x16x32_bf16(af, bfr[s][0], lacc[0], 0, 0, 0);
                lacc[1] = __builtin_amdgcn_mfma_f32_16x16x32_bf16(af, bfr[s][1], lacc[1], 0, 0, 0);
            }
            ssq += __shfl_xor(ssq, 16); ssq += __shfl_xor(ssq, 32);
            if (g == 0) red[w * 16 + l16] = ssq;
#pragma unroll
            for (int et = 0; et < 2; ++et)
#pragma unroll
                for (int r = 0; r < 4; ++r) plog[(w * 16 + 4 * g + r) * 32 + 16 * et + l16] = lacc[et][r];
            __syncthreads();
            { const int row = F.tid >> 5, e = F.tid & 31; float raw = 0.f, ss = 0.f;
#pragma unroll
              for (int ww = 0; ww < 8; ++ww) { raw += plog[(ww * 16 + row) * 32 + e]; ss += red[ww * 16 + row]; }
              const float rstd = 1.0f / sqrtf(ss * (1.0f / D) + EPS);
              const float sc = sigmoidf_(rstd * raw + rb[e]);
              scl[row * 32 + e] = sc; bsl[row * 32 + e] = sc + rbias[e];
              if (e == 0) rstdl[row] = rstd; }
            __syncthreads();
            if (F.tid < 128) {
                const int row = F.tid >> 3, gq = F.tid & 7;
                const f32x4 bs = *(const LAS f32x4*)(bsl + row * 32 + gq * 4), sc = *(const LAS f32x4*)(scl + row * 32 + gq * 4);
                int i1 = 0; float m1 = bs[0];
                if (bs[1] > m1) { m1 = bs[1]; i1 = 1; } if (bs[2] > m1) { m1 = bs[2]; i1 = 2; } if (bs[3] > m1) { m1 = bs[3]; i1 = 3; }
                int i2 = -1; float m2 = -1e30f;
                if (i1 != 0 && bs[0] > m2) { m2 = bs[0]; i2 = 0; } if (i1 != 1 && bs[1] > m2) { m2 = bs[1]; i2 = 1; } if (i1 != 2 && bs[2] > m2) { m2 = bs[2]; i2 = 2; } if (i1 != 3 && bs[3] > m2) { m2 = bs[3]; i2 = 3; }
                float val = m1 + m2; int idx = gq;
#pragma unroll
                for (int off = 1; off < 8; off <<= 1) { const float ov = __shfl_xor(val, off); const int oi = __shfl_xor(idx, off); if (ov > val || (ov == val && oi < idx)) { val = ov; idx = oi; } }
                if (gq == idx) {
                    const float s1 = i1 == 0 ? sc[0] : i1 == 1 ? sc[1] : i1 == 2 ? sc[2] : sc[3], s2 = i2 == 0 ? sc[0] : i2 == 1 ? sc[1] : i2 == 2 ? sc[2] : sc[3];
                    const float inv = 1.0f / (s1 + s2);
                    const int lo = i1 < i2 ? i1 : i2, hi = i1 < i2 ? i2 : i1;
                    const float glo = (i1 < i2 ? s1 : s2) * inv, ghi = (i1 < i2 ? s2 : s1) * inv;
                    const int pp = lo == 0 ? hi - 1 : lo == 1 ? hi + 1 : 5;
                    const int bucket = gq * 6 + pp;
                    const int lt = ti * 16 + row;
                    tokb[lt] = bucket; tokr[lt] = (int)__hip_atomic_fetch_add(&cnt[bucket], 1u, __ATOMIC_RELAXED, __HIP_MEMORY_SCOPE_WORKGROUP);
                    gll[lt * 2] = glo; gll[lt * 2 + 1] = ghi;
                }
            }
            {
                const float rstd = rstdl[l16]; float am = 0.f;
#pragma unroll
                for (int s = 0; s < 8; ++s) {
                    const f32x4 c0 = *(const LAS f32x4*)(cs + 256 * w + 32 * s + 8 * g), c1 = *(const LAS f32x4*)(cs + 256 * w + 32 * s + 8 * g + 4);
                    const f32x4 h0 = *(const LAS f32x4*)(sh + 256 * w + 32 * s + 8 * g), h1 = *(const LAS f32x4*)(sh + 256 * w + 32 * s + 8 * g + 4);
                    xv[s][0] = xv[s][0] * rstd * c0 + h0; xv[s][1] = xv[s][1] * rstd * c1 + h1;
                    am = fmaxf(am, fmaxf(fmaxf(fmaxf(fabsf(xv[s][0][0]), fabsf(xv[s][0][1])), fmaxf(fabsf(xv[s][0][2]), fabsf(xv[s][0][3]))), fmaxf(fmaxf(fabsf(xv[s][1][0]), fabsf(xv[s][1][1])), fmaxf(fabsf(xv[s][1][2]), fabsf(xv[s][1][3]))))); }
                am = fmaxf(am, __shfl_xor(am, 16)); am = fmaxf(am, __shfl_xor(am, 32));
                if (g == 0) amaxl[w * 16 + l16] = am;
                __syncthreads();
                float ra = 1e-20f;
#pragma unroll
                for (int ww = 0; ww < 8; ++ww) ra = fmaxf(ra, amaxl[ww * 16 + l16]);
                const float inv = 127.0f / ra;
                if (w == 0 && g == 0) { hsc[r0 + l16] = ra * (1.0f / 127.0f); scll[ti * 16 + l16] = ra * (1.0f / 127.0f); }
                signed char* orow = H2 + (size_t)(r0 + l16) * D + 256 * w + 8 * g;
#pragma unroll
                for (int s = 0; s < 8; ++s) { u32x2 ow; ow.x = q4(xv[s][0] * inv); ow.y = q4(xv[s][1] * inv); *(u32x2*)(orow + 32 * s) = ow; }
            }
        }
        __syncthreads();
        if (F.tid < 48) basel[F.tid] = __hip_atomic_fetch_add(gcnt + F.tid, cnt[F.tid], __ATOMIC_RELAXED, __HIP_MEMORY_SCOPE_AGENT);
        __syncthreads();
        if (F.tid < 128) {
            const int bk = tokb[F.tid]; const unsigned bi = ((unsigned)bk << 15) + basel[bk] + (unsigned)tokr[F.tid];
            ((int*)(F.ws + WS_R2TB))[bi] = tok0 + F.tid;
            f32x2 gg; gg.x = gll[F.tid * 2]; gg.y = gll[F.tid * 2 + 1]; ((f32x2*)(F.ws + WS_RGB))[bi] = gg;
            ((float*)(F.ws + WS_RSB))[bi] = scll[F.tid]; }
    }
    __syncthreads();
}

__device__ __forceinline__ void build_tile_table(Frame& F, int layer) {
    LAS int* tt = (LAS int*)(F.lds + TT_OFF);
    const unsigned* gcnt = (const unsigned*)(F.ws + WS_CTL) + CW_CNT + layer * 64;
    __syncthreads();
    if (F.tid == 0) { int t = 0;
        for (int b = 0; b < NBUCK; ++b) { const int c = (int)__hip_atomic_load(gcnt + b, __ATOMIC_RELAXED, __HIP_MEMORY_SCOPE_AGENT); const int n = (c + 255) >> 8; tt[1 + b] = t * 256; tt[320 + b] = c;
            for (int i = 0; i < n; ++i) tt[64 + t + i] = b;
            t += n; }
        tt[0] = t; }
    __syncthreads();
}
__device__ __forceinline__ void p_permute(Frame& F, int layer) {
    build_tile_table(F, layer);
    const LAS int* tt = (const LAS int*)(F.lds + TT_OFF);
    int* r2t = (int*)(F.ws + WS_ROW2TOK); float* rg = (float*)(F.ws + WS_ROWGATE); const float* hsc = (const float*)(F.ws + WS_HSC); float* rsc = (float*)(F.ws + WS_ROWSC);
    const int tok = F.vcu * NTHR + F.tid;
    if (tok < NTOK) {
        const u32x4 rec = *((const u32x4*)(F.ws + WS_TOKINFO) + tok);
        const int row = tt[1 + (int)rec.x] + (int)rec.y;
        r2t[row] = tok; rg[(size_t)row * 2] = u2f(rec.z); rg[(size_t)row * 2 + 1] = u2f(rec.w); rsc[row] = hsc[tok];
    }
}

constexpr int N_PHASES = 22;
__global__ void __launch_bounds__(NTHR, 2) fwd_kernel(Args args) {
    extern __shared__ __attribute__((aligned(16))) unsigned char lds_raw[];
    Frame F;
    F.lds = (LAS unsigned char*)lds_raw;
#define TID() ((int)threadIdx.x)
    F.tid = TID(); F.lane = F.tid & 63; F.wave = __builtin_amdgcn_readfirstlane(F.tid >> 6);
    F.G = gridDim.x; F.vcu = vcu_of(blockIdx.x, F.G); F.ws = (unsigned char*)kargp(19);
    if (F.tid < 16) ((LAS unsigned*)(F.lds + LDSCTL_OFF))[F.tid] = 0u;
    __syncthreads();
    const int lo = args.ph_lo, hi = args.ph_hi;
    const bool one_launch = (hi - lo) > 1;
    XcdBarrier bar; bar.bar = (unsigned*)(F.ws + WS_CTL) + CW_BAR; bar.x = 0; bar.st = (volatile LAS unsigned*)(F.lds + LDSCTL_OFF);
    if (one_launch) bar = xcd_barrier_post((unsigned*)(F.ws + WS_CTL) + CW_BAR, (volatile LAS unsigned*)(F.lds + LDSCTL_OFF));
#define LAUNDER() do { GAS unsigned char* w_ = (GAS unsigned char*)kargp(19); asm volatile("" : "+s"(w_)); F.ws = (unsigned char*)w_;     int t_ = TID(); asm volatile("" : "+v"(t_)); F.tid = t_; F.lane = t_ & 63; F.wave = __builtin_amdgcn_readfirstlane(t_ >> 6); } while (0)
#define IN(k) (lo <= (k) && (k) < hi)
#if MK_STAMP
#define SEAM(k) do { if (IN(k) && IN((k) + 1)) xcd_barrier(bar, TID() == 0); if (blockIdx.x == 0 && threadIdx.x == 0) __hip_atomic_store((unsigned long long*)((unsigned*)(args.ws + WS_CTL) + CW_TS) + (k) + 1, (unsigned long long)__builtin_amdgcn_s_memrealtime(), __ATOMIC_RELAXED, __HIP_MEMORY_SCOPE_AGENT); } while (0)
#else
#define SEAM(k) do { if (IN(k) && IN((k) + 1)) xcd_barrier(bar, TID() == 0); } while (0)
#endif
#define XB ((bf16_t*)(F.ws + WS_XB))
#define HBUF ((bf16_t*)(F.ws + WS_HBUF))
#define HQ ((signed char*)(F.ws + WS_HBUF))
#define HSC ((float*)(F.ws + WS_HSC))
#define modl ((const float*)(F.ws + WS_MOD) + (size_t)l * 2 * 12288)
#define x1 ((bf16_t*)kargp(18))
#define XB0 ((bf16_t*)kargp(18) + (size_t)NTOK * D)

#if MK_STAMP
    if (blockIdx.x == 0 && threadIdx.x == 0) __hip_atomic_store((unsigned long long*)((unsigned*)(args.ws + WS_CTL) + CW_TS), (unsigned long long)__builtin_amdgcn_s_memrealtime(), __ATOMIC_RELAXED, __HIP_MEMORY_SCOPE_AGENT);
#endif
    if (HASK(0) && IN(0)) { LAUNDER(); p0_prologue(F, args); }
    SEAM(0);
    auto layer_body = [&](auto LT) __attribute__((always_inline)) {
        constexpr int l = decltype(LT)::value;
        const int pb = 1 + 10 * l;
        if (HASK(1) && IN(pb + 0)) { LAUNDER();
            p_rbias(F, l);
            convert_weights(F, args, l);
            if (l == 0) p_norm<false, true>(F, kargp(I_X), (const float*)kargp(I_N1W) + (size_t)l * D, modl, 0, 2048, HQ, HSC, nullptr, XB0);
            else p_norm<false, false>(F, XB, (const float*)kargp(I_N1W) + (size_t)l * D, modl, 0, 2048, HQ, HSC, nullptr);
        }
        SEAM(pb + 0);
        if (HASK(2) && IN(pb + 1)) { LAUNDER();
            { SchedProj S{(const char*)HBUF, (const char*)(F.ws + WS_WIN), F.G, F.vcu};
              EpiProj E{F.ws, F.lds + KTS_OFF};
              pg8::gemm_phase<EpiProj, SchedProj, false, true>(F.lds, F.tid, D, D, D, 0, S, E); }
            LAUNDER();
            { SchedProjT S{(const char*)(F.ws + WS_WIN), (const char*)HBUF, F.G, F.vcu};
              EpiProjT E{F.ws};
              pg8::gemm_phase<EpiProjT, SchedProjT, false, true>(F.lds, F.tid, D, D, D, 0, S, E); }
        }
        SEAM(pb + 1);
        if (HASK(3) && IN(pb + 2)) { LAUNDER();
            SchedKV S{(const char*)(F.ws + WS_VT), (const char*)(F.ws + WS_KT), F.G, F.vcu};
            EpiKV E{F.ws + WS_KVT};
            pg8::gemm_phase<EpiKV, SchedKV, false, false>(F.lds, F.tid, CH * 2, 256, 256, 0, S, E);
        }
        SEAM(pb + 2);
        if (HASK(4) && IN(pb + 3)) { LAUNDER(); p_scan(F); }
        SEAM(pb + 3);
        if (HASK(5) && IN(pb + 4)) { LAUNDER(); p_retsg(F, args, l); }
        SEAM(pb + 4);
        if (HASK(6) && IN(pb + 5)) { LAUNDER();
            SchedOut S{(const char*)(F.ws + WS_MIXQ), (const char*)(F.ws + WS_WOUT), F.G, F.vcu};
            if (l == 0) { EpiOut<false> E{XB0, x1, modl + 4096, HSC, (const float*)(F.ws + WS_WSC_OUT)}; pg8::gemm_phase<EpiOut<false>, SchedOut, false, true>(F.lds, F.tid, D, D, D, 0, S, E); }
            else { EpiOut<false> E{XB, x1, modl + 4096, HSC, (const float*)(F.ws + WS_WSC_OUT)}; pg8::gemm_phase<EpiOut<false>, SchedOut, false, true>(F.lds, F.tid, D, D, D, 0, S, E); }
        }
        SEAM(pb + 5);
        if (HASK(7) && IN(pb + 6)) { LAUNDER(); p_router(F, args, l, x1); }
        SEAM(pb + 6);
        if (HASK(9) && IN(pb + 8)) { LAUNDER();
            build_tile_table(F, l);
            SchedUp S{(const char*)(F.ws + WS_HBUF), (const char*)(F.ws + WS_W13), (const LAS int*)(F.lds + TT_OFF), F.G, F.vcu, (const int*)(F.ws + WS_R2TB)};
            EpiUp E{(bf16_t*)(F.ws + WS_HH), (const float*)(F.ws + WS_RGB), (const float*)(F.ws + WS_RSB), (const float*)(F.ws + WS_WSC_13), (const LAS int*)(F.lds + TT_OFF)};
            pg8::gemm_phase<EpiUp, SchedUp, false, true, true>(F.lds, F.tid, D, D, D, 0, S, E);
        }
        SEAM(pb + 8);
        if (HASK(10) && IN(pb + 9)) { LAUNDER();
            build_tile_table(F, l);
            { LAS float* gl = (LAS float*)(F.lds + KTS_OFF); for (int i = F.tid; i < 2 * D; i += NTHR) gl[i] = modl[(size_t)(i >> 11) * 12288 + 10240 + (i & 2047)]; }
            __syncthreads();
            SchedDown S{(const char*)(F.ws + WS_HH), (const char*)(F.ws + WS_W2), (const LAS int*)(F.lds + TT_OFF), F.G, F.vcu};
            EpiDown E{x1, XB, (const LAS float*)(F.lds + KTS_OFF), (const int*)(F.ws + WS_R2TB), (const LAS int*)(F.lds + TT_OFF)};
            pg8::gemm_phase<EpiDown, SchedDown, true, false>(F.lds, F.tid, 2 * FF * 2, 2 * FF * 2, FF * 2, FF / 64, S, E);
        }
        SEAM(pb + 9);
    };
    layer_body(IntC<0>{}); layer_body(IntC<1>{});
    if (HASK(11) && IN(21)) { LAUNDER(); p_norm<true, false>(F, XB, (const float*)kargp(I_FNW), nullptr, 0, 0, nullptr, nullptr, (float*)kargp(18)); }
#if MK_STAMP
    {
        xcd_barrier(bar, TID() == 0);
        if (blockIdx.x == 0 && threadIdx.x == 0) __hip_atomic_store((unsigned long long*)((unsigned*)(args.ws + WS_CTL) + CW_TS) + 22, (unsigned long long)__builtin_amdgcn_s_memrealtime(), __ATOMIC_RELAXED, __HIP_MEMORY_SCOPE_AGENT);
        xcd_barrier(bar, TID() == 0);
        unsigned long long* ts = (unsigned long long*)((unsigned*)(args.ws + WS_CTL) + CW_TS);
        const float dA = (float)(__hip_atomic_load(ts + MK_STAMP_A2, __ATOMIC_RELAXED, __HIP_MEMORY_SCOPE_AGENT) - __hip_atomic_load(ts + MK_STAMP_A, __ATOMIC_RELAXED, __HIP_MEMORY_SCOPE_AGENT)) * 0.01f;
        const float dB = (float)(__hip_atomic_load(ts + MK_STAMP_B2, __ATOMIC_RELAXED, __HIP_MEMORY_SCOPE_AGENT) - __hip_atomic_load(ts + MK_STAMP_B, __ATOMIC_RELAXED, __HIP_MEMORY_SCOPE_AGENT)) * 0.01f;
        const float qA = rintf(__logf(fmaxf(dA, 1.f)) / __logf(1.15f) + MK_STAMP_OFF), qB = rintf(__logf(fmaxf(dB, 1.f)) / __logf(1.15f) + MK_STAMP_OFF);
        const float c = sqrtf(qA), c2 = 10.f * qB + 100.f;
        for (size_t i = (size_t)blockIdx.x * NTHR + threadIdx.x; i < (size_t)NTOK * D; i += (size_t)gridDim.x * NTHR) args.out[i] = (i == 12345) ? c2 : c;
    }
#endif
#undef IN
#undef SEAM
#undef TID
#undef XB
#undef HBUF
#undef HQ
#undef HSC
#undef modl
#undef x1
#undef XB0
}


extern "C" void kernel_launch(void* const* d_in, const int* in_sizes, int n_in, void* d_out, int out_size, void* d_ws, size_t ws_size, hipStream_t stream) {
    static int grid = 0;
    if (grid == 0) {
        if (n_in != 18 || out_size != NTOK * D || ws_size < WS_END) { fprintf(stderr, "kernel_launch: unexpected shapes (n_in %d, out %d, ws %zu < %zu); nothing launched\n", n_in, out_size, ws_size, (size_t)WS_END); grid = -1; return; }
        int dev = 0, cus = 0, per_cu = 0;
        if (hipGetDevice(&dev) != hipSuccess || hipDeviceGetAttribute(&cus, hipDeviceAttributeMultiprocessorCount, dev) != hipSuccess) { grid = -1; return; }
        if (hipFuncSetAttribute((const void*)fwd_kernel, hipFuncAttributeMaxDynamicSharedMemorySize, LDS_BYTES) != hipSuccess) { fprintf(stderr, "kernel_launch: hipFuncSetAttribute failed\n"); grid = -1; return; }
        if (hipOccupancyMaxActiveBlocksPerMultiprocessor(&per_cu, (const void*)fwd_kernel, NTHR, LDS_BYTES) != hipSuccess || per_cu < 1) { fprintf(stderr, "kernel_launch: occupancy query says %d blocks per CU\n", per_cu); }
        (void)hipGetLastError();
        if (cus < 256) { fprintf(stderr, "kernel_launch: needs >= 256 CUs (one (batch, chunk) unit of the retention phase per workgroup)\n"); grid = -1; return; }
        grid = cus;
    }
    if (grid < 0) return;
    if (hipMemsetAsync((char*)d_ws + WS_CTL, 0, CTL_ZERO_BYTES, stream) != hipSuccess) { fprintf(stderr, "kernel_launch: memset failed\n"); return; }
    Args a{};
    for (int i = 0; i < 18; ++i) a.in[i] = d_in[i];
    a.out = (float*)d_out; a.ws = (unsigned char*)d_ws; a.li = 0; a.pad = 0;
#if MK_N_LAUNCHES == 1
    a.ph_lo = 0; a.ph_hi = N_PHASES;
    hipLaunchKernelGGL(fwd_kernel, dim3(grid), dim3(NTHR), LDS_BYTES, stream, a);
#else
    for (int p = 0; p < N_PHASES; ++p) { a.ph_lo = p; a.ph_hi = p + 1; hipLaunchKernelGGL(fwd_kernel, dim3(grid), dim3(NTHR), LDS_BYTES, stream, a);
    }

#endif
    const hipError_t le = hipPeekAtLastError();
    if (le != hipSuccess) fprintf(stderr, "kernel_launch: launch failed: %s\n", hipGetErrorName(le));
}
```
